# Optimizing an MI355X kernel written in HIP

```python
import jax, jax.numpy as jnp
from jax import lax
import numpy as np

D_MODEL = 4096
BATCH = 4
SEQ = 2048
DEPTH = 2
DEC_BATCH = 32
DEC_SEQ = 8
PAST_LEN = 16384
PAGE_SIZE = 128

MIX_WIDTH = D_MODEL
ATT_WIDTH = MIX_WIDTH // 2
GM_WIDTH = MIX_WIDTH - ATT_WIDTH
HEAD_DIM = 64
N_HEADS = ATT_WIDTH // HEAD_DIM
N_KV_HEADS = 4
GQA_GROUP = N_HEADS // N_KV_HEADS
WINDOW = 128
CHUNK = 128
GM_HEAD_DIM = 128
GM_HEADS = GM_WIDTH // GM_HEAD_DIM
D_FF = ((8 * D_MODEL // 3 + 255) // 256) * 256
CONV_W = 3
EPS = 1e-6
Q_COLS = N_HEADS * HEAD_DIM
KV_COLS = N_KV_HEADS * HEAD_DIM
IN_COLS = Q_COLS + 2 * KV_COLS + 2 * GM_WIDTH

kernel_name = "hymba_style_swa_sink_gmlp_convffn_step"


def rmsnorm(x, g):
    xf = x.astype(jnp.float32)
    y = xf * lax.rsqrt(jnp.mean(xf * xf, axis=-1, keepdims=True) + EPS)
    return (y * g.astype(jnp.float32)).astype(x.dtype)


def sink_attention(q, k, v, q_pos, k_pos, sinks):
    B, N, Tq, H, D = q.shape
    qg = q.reshape(B, N, Tq, N_KV_HEADS, GQA_GROUP, D)
    s = jnp.einsum("bnqkgd,bnskd->bnkgqs", qg, k,
                   preferred_element_type=jnp.float32) * (D ** -0.5)
    rel = q_pos[:, :, None] - k_pos[:, None, :]
    mask = (rel >= 0) & (rel < WINDOW) & (k_pos[:, None, :] >= 0)
    s = jnp.where(mask[None, :, None, None], s, -jnp.inf)
    sink = sinks.astype(jnp.float32).reshape(N_KV_HEADS, GQA_GROUP)[None, None, :, :, None, None]
    full = jnp.concatenate([s, jnp.broadcast_to(sink, s.shape[:-1] + (1,))], axis=-1)
    p = jax.nn.softmax(full, axis=-1)[..., :-1]
    o = jnp.einsum("bnkgqs,bnskd->bnqkgd", p.astype(v.dtype), v)
    return o.reshape(B, N, Tq, H * D)


def swa_prompt(q, k, v, sinks):
    B, S = q.shape[:2]
    N = S // WINDOW
    qb = q.reshape(B, N, WINDOW, N_HEADS, HEAD_DIM)
    kb = k.reshape(B, N, WINDOW, N_KV_HEADS, HEAD_DIM)
    vb = v.reshape(B, N, WINDOW, N_KV_HEADS, HEAD_DIM)
    pad = ((0, 0), (1, 0), (0, 0), (0, 0), (0, 0))
    kk = jnp.concatenate([jnp.pad(kb, pad)[:, :-1], kb], axis=2)
    vv = jnp.concatenate([jnp.pad(vb, pad)[:, :-1], vb], axis=2)
    start = jnp.arange(N)[:, None] * WINDOW
    q_pos = start + jnp.arange(WINDOW)[None]
    k_pos = start - WINDOW + jnp.arange(2 * WINDOW)[None]
    o = sink_attention(qb, kk, vv, q_pos, k_pos, sinks)
    return o.reshape(B, S, ATT_WIDTH)


def swa_sample(q, k, v, k_buf, v_buf, sinks):
    B, T = q.shape[:2]
    L = k_buf.shape[1]
    kk = jnp.concatenate([k_buf, k], axis=1)[:, None]
    vv = jnp.concatenate([v_buf, v], axis=1)[:, None]
    q_pos = (PAST_LEN + jnp.arange(T))[None]
    k_pos = (PAST_LEN - L + jnp.arange(L + T))[None]
    o = sink_attention(q[:, None], kk, vv, q_pos, k_pos, sinks)
    return o.reshape(B, T, ATT_WIDTH)


def chunk_sgu(u, v, w_s, b_s):
    B, T = u.shape[:2]
    n = -(-T // CHUNK)
    vp = jnp.pad(v, ((0, 0), (0, n * CHUNK - T), (0, 0), (0, 0)))
    vp = vp.reshape(B, n, CHUNK, GM_HEADS, GM_HEAD_DIM)
    causal = jnp.tril(jnp.ones((CHUNK, CHUNK), dtype=bool))
    w = jnp.where(causal[None], w_s, jnp.zeros_like(w_s))
    mixed = jnp.einsum("hts,bnshe->bnthe", w, vp) + b_s.T[None, None, :, :, None]
    mixed = mixed.reshape(B, n * CHUNK, GM_HEADS, GM_HEAD_DIM)[:, :T]
    return (u * mixed).reshape(B, T, GM_WIDTH)


def token_mixer(h, k_buf, v_buf, w_in, w_out, sinks, w_s, b_s, g_gm):
    B, T, _ = h.shape
    z = jnp.einsum("btd,dc->btc", h, w_in)
    q = z[..., :Q_COLS].reshape(B, T, N_HEADS, HEAD_DIM)
    k = z[..., Q_COLS:Q_COLS + KV_COLS].reshape(B, T, N_KV_HEADS, HEAD_DIM)
    v = z[..., Q_COLS + KV_COLS:Q_COLS + 2 * KV_COLS].reshape(B, T, N_KV_HEADS, HEAD_DIM)
    gm = jax.nn.gelu(z[..., Q_COLS + 2 * KV_COLS:], approximate=True)
    u = gm[..., :GM_WIDTH].reshape(B, T, GM_HEADS, GM_HEAD_DIM)
    gv = rmsnorm(gm[..., GM_WIDTH:], g_gm).reshape(B, T, GM_HEADS, GM_HEAD_DIM)
    if k_buf is None:
        att = swa_prompt(q, k, v, sinks)
        keep = min(WINDOW, T)
        new_k, new_v = k[:, T - keep:], v[:, T - keep:]
    else:
        att = swa_sample(q, k, v, k_buf, v_buf, sinks)
        new_k, new_v = k, v
    gmo = chunk_sgu(u, gv, w_s, b_s)
    y = jnp.einsum("btc,cd->btd", jnp.concatenate([att, gmo], axis=-1), w_out)
    return y, new_k, new_v, gv


def conv_ffn(h, conv_buf, w_gate, w_up, w_down, conv_w, conv_b):
    T = h.shape[1]
    g = jnp.einsum("btd,df->btf", h, w_gate)
    up = jnp.einsum("btd,df->btf", h, w_up)
    ext = jnp.concatenate([conv_buf.astype(g.dtype), g], axis=1)
    c = conv_b
    for j in range(CONV_W):
        c = c + conv_w[j] * ext[:, j:j + T]
    a = jax.nn.gelu(c, approximate=True) * up
    y = jnp.einsum("btf,fd->btd", a, w_down)
    return y, ext[:, ext.shape[1] - (CONV_W - 1):]


def decoder_layer(x, k_buf, v_buf, conv_buf, w_in, w_out, sinks, w_s, b_s, g_gm,
                  g_pre_mix, g_post_mix, g_pre_ffn, g_post_ffn,
                  w_gate, w_up, w_down, conv_w, conv_b):
    m, new_k, new_v, gv = token_mixer(rmsnorm(x, g_pre_mix), k_buf, v_buf,
                                      w_in, w_out, sinks, w_s, b_s, g_gm)
    x = x + rmsnorm(m, g_post_mix)
    f, new_conv = conv_ffn(rmsnorm(x, g_pre_ffn), conv_buf, w_gate, w_up, w_down, conv_w, conv_b)
    x = x + rmsnorm(f, g_post_ffn)
    return x, new_k, new_v, new_conv, gv


def setup_inputs(seed: int = 0) -> dict:
    key = jax.random.key(seed)
    ks = jax.random.split(key, 24)
    f32 = jnp.float32
    nrm = lambda k, shape, scale: (jax.random.normal(k, shape, f32) * scale)
    buf = min(WINDOW, PAST_LEN)
    return {
        "x_prompt": nrm(ks[0], (BATCH, SEQ, D_MODEL), 1.0),
        "x_sample": nrm(ks[1], (DEC_BATCH, DEC_SEQ, D_MODEL), 1.0),
        "state_swa_k": nrm(ks[2], (DEPTH, DEC_BATCH, buf, N_KV_HEADS, HEAD_DIM), 1.0),
        "state_swa_v": nrm(ks[3], (DEPTH, DEC_BATCH, buf, N_KV_HEADS, HEAD_DIM), 1.0),
        "state_conv": nrm(ks[4], (DEPTH, DEC_BATCH, CONV_W - 1, D_FF), 1.0),
        "w_in": nrm(ks[5], (DEPTH, D_MODEL, IN_COLS), D_MODEL ** -0.5),
        "w_out": nrm(ks[6], (DEPTH, MIX_WIDTH, D_MODEL), MIX_WIDTH ** -0.5),
        "attn_sinks": nrm(ks[7], (DEPTH, N_HEADS), 0.5),
        "gm_spatial": nrm(ks[8], (DEPTH, GM_HEADS, CHUNK, CHUNK), CHUNK ** -0.5),
        "gm_bias": 1.0 + nrm(ks[9], (DEPTH, GM_HEADS, CHUNK), 0.1),
        "gm_norm": 1.0 + nrm(ks[10], (DEPTH, GM_WIDTH), 0.05),
        "norm_pre_mix": 1.0 + nrm(ks[11], (DEPTH, D_MODEL), 0.05),
        "norm_post_mix": 1.0 + nrm(ks[12], (DEPTH, D_MODEL), 0.05),
        "norm_pre_ffn": 1.0 + nrm(ks[13], (DEPTH, D_MODEL), 0.05),
        "norm_post_ffn": 1.0 + nrm(ks[14], (DEPTH, D_MODEL), 0.05),
        "w_ffn_gate": nrm(ks[15], (DEPTH, D_MODEL, D_FF), D_MODEL ** -0.5),
        "w_ffn_up": nrm(ks[16], (DEPTH, D_MODEL, D_FF), D_MODEL ** -0.5),
        "w_ffn_down": nrm(ks[17], (DEPTH, D_FF, D_MODEL), D_FF ** -0.5),
        "conv_w": nrm(ks[18], (DEPTH, CONV_W, D_FF), CONV_W ** -0.5),
        "conv_b": nrm(ks[19], (DEPTH, D_FF), 0.02),
    }


def reference(x_prompt, x_sample, state_swa_k, state_swa_v, state_conv,
              w_in, w_out, attn_sinks, gm_spatial, gm_bias, gm_norm,
              norm_pre_mix, norm_post_mix, norm_pre_ffn, norm_post_ffn,
              w_ffn_gate, w_ffn_up, w_ffn_down, conv_w, conv_b):
    xp, xs = x_prompt, x_sample
    p_k, p_v, p_c, s_k, s_v, s_c, s_g = [], [], [], [], [], [], []
    zero_conv = jnp.zeros((xp.shape[0], CONV_W - 1, D_FF), xp.dtype)
    for l in range(DEPTH):
        w = (w_in[l], w_out[l], attn_sinks[l], gm_spatial[l], gm_bias[l], gm_norm[l],
             norm_pre_mix[l], norm_post_mix[l], norm_pre_ffn[l], norm_post_ffn[l],
             w_ffn_gate[l], w_ffn_up[l], w_ffn_down[l], conv_w[l], conv_b[l])
        xp, nk, nv, nc, _ = decoder_layer(xp, None, None, zero_conv, *w)
        p_k.append(nk); p_v.append(nv); p_c.append(nc)
        xs, nk, nv, nc, gv = decoder_layer(xs, state_swa_k[l], state_swa_v[l], state_conv[l], *w)
        s_k.append(nk); s_v.append(nv); s_c.append(nc); s_g.append(gv)
    return (xp, xs,
            jnp.stack(p_k), jnp.stack(p_v), jnp.stack(p_c),
            jnp.stack(s_k), jnp.stack(s_v), jnp.stack(s_c), jnp.stack(s_g))
```

```cpp
#include <hip/hip_runtime.h>
#include <cstdio>
#include <cstdint>
#ifndef MK_PER_PHASE
#define MK_PER_PHASE 0
#endif
namespace pg8 {
#define PG8_LAS __attribute__((address_space(3)))
typedef unsigned short bf16_t;
typedef short bf16x8 __attribute__((ext_vector_type(8)));
typedef float f32x4 __attribute__((ext_vector_type(4)));
typedef unsigned u32x4 __attribute__((ext_vector_type(4)));
constexpr int BM = 256, BK = 64, HALF = 128, HTB = HALF * BK * 2  , STAGE_BYTES = 8 * HTB, NXCD = 8, WGM = 8;

__host__ __device__ __forceinline__ int lds_byte(int r, int c) { const int st = (r >> 4) * 2 + (c >> 5), rr = r & 15, cc = c & 31, ob = rr * 64 + cc * 2; return st * 1024 + (ob ^ (((ob >> 9) & 1) << 5)); }
__host__ __device__ __forceinline__ void stage_rc(int b, int& R, int& C) { const int st = b / 1024, sb = b % 1024, swz = sb ^ (((sb >> 9) & 1) << 5); R = (st >> 1) * 16 + swz / 64; C = (st & 1) * 32 + (swz % 64) / 2; }
__host__ __device__ __forceinline__ int perm32(int rho) { const int n = rho >> 4, i = rho & 15; return 8 * (i >> 2) + 4 * n + (i & 3); }

struct Unit { int pm, pn; };
struct Gemm { const bf16_t* A; const bf16_t* Bt; int M, N, K; };

struct StaticOrder {
    int nM, nN, nwg, G, c;
    __host__ __device__ void init(int M, int N, int G_, int c_) { nM = M / BM; nN = N / BM; nwg = nM * nN; G = G_; c = c_; }
    __host__ __device__ bool next(int i, Unit& u) const {
        const long L = (long)i * G + c; if (L >= nwg) return false;
        int wgid = (int)L; { const int q = nwg / NXCD, r = nwg % NXCD, xcd = wgid % NXCD, off = wgid / NXCD; wgid = (xcd < r ? xcd * (q + 1) : r * (q + 1) + (xcd - r) * q) + off; }
        const int nig = WGM * nN, gid = wgid / nig, fm = gid * WGM, gsz = (nM - fm) < WGM ? (nM - fm) : WGM;
        u.pm = fm + ((wgid % nig) % gsz); u.pn = (wgid % nig) / gsz; return true;
    }
    __device__ __forceinline__ void a_ready(const Unit&) const {}
    __device__ __forceinline__ void done(const Unit&) const {}
};

__device__ __forceinline__ unsigned cvt_pk_bf16(float lo, float hi) { unsigned r; asm volatile("v_cvt_pk_bf16_f32 %0, %1, %2" : "=v"(r) : "v"(lo), "v"(hi)); return r; }
typedef float f32x2 __attribute__((ext_vector_type(2)));
__device__ __forceinline__ float gelu_tanh(float x) {
    const float t = x * (-2.302208198f - 0.1029432397f * x * x);
    const float e = __builtin_amdgcn_exp2f(t);
    return x * __builtin_amdgcn_rcpf(1.0f + e);
}
__device__ __forceinline__ f32x4 gelu4(f32x4 v) { return (f32x4){gelu_tanh(v[0]), gelu_tanh(v[1]), gelu_tanh(v[2]), gelu_tanh(v[3])}; }
__device__ __forceinline__ u32x4 pack8(f32x4 v0, f32x4 v1) { u32x4 w; w.x = cvt_pk_bf16(v0[0], v0[1]); w.y = cvt_pk_bf16(v0[2], v0[3]); w.z = cvt_pk_bf16(v1[0], v1[1]); w.w = cvt_pk_bf16(v1[2], v1[3]); return w; }

struct EpiPlain {
    static constexpr bool PERM = true, AFTER_DRAIN = false;
    bf16_t* O; int ldc;
    __device__ __forceinline__ void operator()(const f32x4 (&acc)[2][2][4][2], const Unit& u, int wr, int wc, int fr, int fq) const {
        asm volatile("" : "+v"(fr), "+v"(fq));
        const int row0 = u.pm * BM + wr * 64 + fr, col0 = u.pn * BM + wc * 32 + 8 * fq;
#pragma unroll
        for (int ai = 0; ai < 2; ++ai)
#pragma unroll
            for (int m = 0; m < 4; ++m) { bf16_t* rowp = O + (size_t)(row0 + ai * HALF + m * 16) * ldc + col0;
#pragma unroll
                for (int bj = 0; bj < 2; ++bj) *(u32x4*)(rowp + bj * HALF) = pack8(acc[ai][bj][m][0], acc[ai][bj][m][1]); }
    }
};

struct EpiIn {
    static constexpr bool PERM = true, AFTER_DRAIN = false;
    bf16_t* Z; float* ssq;
    float *out_pk, *out_pv, *out_sk, *out_sv;
    __device__ __forceinline__ void operator()(const f32x4 (&acc)[2][2][4][2], const Unit& u, int wr, int wc, int fr, int fq) const {
        constexpr int LDZ = 6656;
        asm volatile("" : "+v"(fr), "+v"(fq));
        const int pn = u.pn;
        const bool is_q = pn < 8, is_kv = (pn == 8) || (pn == 9), is_gelu = pn >= 10, is_v = pn >= 18;
        const float scale = is_q ? 0.125f : 1.0f;
        const int rt0 = wr * 64 + fr, col0 = pn * BM + wc * 32 + 8 * fq, c0 = wc * 32 + 8 * fq;
        bf16_t* zb = Z + (size_t)(u.pm * BM + rt0) * LDZ + col0;
        const int pidx = (pn - 18) * 4 + wc;
        float* fo = nullptr; bool fo_hi_only = false;
        if (is_kv) { if (u.pm == 32) fo = ((pn == 8) ? out_sk : out_sv) + (size_t)rt0 * 256 + c0;
                     else if ((u.pm & 7) == 7) { fo = ((pn == 8) ? out_pk : out_pv) + ((size_t)(u.pm >> 3) * 128 + rt0 - 128) * 256 + c0; fo_hi_only = true; } }
#pragma unroll
        for (int ai = 0; ai < 2; ++ai)
#pragma unroll
            for (int m = 0; m < 4; ++m) { const int ro = ai * HALF + m * 16; float s = 0.f;
#pragma unroll
                for (int bj = 0; bj < 2; ++bj) { f32x4 v0 = acc[ai][bj][m][0] * scale, v1 = acc[ai][bj][m][1] * scale;
                    if (is_gelu) { v0 = gelu4(v0); v1 = gelu4(v1); }
                    if (is_v) s += (v0[0] * v0[0] + v0[1] * v0[1]) + (v0[2] * v0[2] + v0[3] * v0[3]) + (v1[0] * v1[0] + v1[1] * v1[1]) + (v1[2] * v1[2] + v1[3] * v1[3]);
                    *(u32x4*)(zb + (size_t)ro * LDZ + bj * HALF) = pack8(v0, v1);
                    if (fo != nullptr && (!fo_hi_only || ai == 1)) { float* d = fo + (size_t)ro * 256 + bj * HALF; *(f32x4*)d = v0; *(f32x4*)(d + 4) = v1; } }
                if (is_v) { s += __shfl_xor(s, 16); s += __shfl_xor(s, 32); if (fq == 0) ssq[(size_t)(u.pm * BM + rt0 + ro) * 32 + pidx] = s; }
                asm volatile("" ::: "memory"); }
    }
};

__device__ __forceinline__ float dpp_shr1(float old, float src) { return __builtin_bit_cast(float, __builtin_amdgcn_update_dpp(__builtin_bit_cast(int, old), __builtin_bit_cast(int, src), 0x111, 0xf, 0xf, false)); }
__device__ __forceinline__ float dpp_shr2(float old, float src) { return __builtin_bit_cast(float, __builtin_amdgcn_update_dpp(__builtin_bit_cast(int, old), __builtin_bit_cast(int, src), 0x112, 0xf, 0xf, false)); }
__device__ __forceinline__ float dpp_ror1(float src) { return __builtin_bit_cast(float, __builtin_amdgcn_update_dpp(0, __builtin_bit_cast(int, src), 0x121, 0xf, 0xf, false)); }
__device__ __forceinline__ float dpp_ror2(float src) { return __builtin_bit_cast(float, __builtin_amdgcn_update_dpp(0, __builtin_bit_cast(int, src), 0x122, 0xf, 0xf, false)); }

struct EpiGU {
    static constexpr bool PERM = true, AFTER_DRAIN = false;
    bf16_t* A; float* halo;
    const float *cw, *cb, *state;
    float *out_pc, *out_sc;
    __device__ __forceinline__ void operator()(const f32x4 (&acc)[2][2][4][2], const Unit& u, int wr, int wc, int fr, int fq) const {
        constexpr int FFN = 11008;
        asm volatile("" : "+v"(fr), "+v"(fq));
        const int f0 = u.pn * 128 + wc * 32 + 8 * fq;
        f32x4 w0[2], w1[2], w2[2], bb[2];
#pragma unroll
        for (int n = 0; n < 2; ++n) { w0[n] = *(const f32x4*)(cw + f0 + 4 * n); w1[n] = *(const f32x4*)(cw + FFN + f0 + 4 * n); w2[n] = *(const f32x4*)(cw + 2 * FFN + f0 + 4 * n); bb[n] = *(const f32x4*)(cb + f0 + 4 * n); }
        const bool smp = (u.pm == 32);
        const int t = fr & 7;
        bf16_t* ab = A + (size_t)(u.pm * BM + wr * 64 + fr) * FFN + f0;
#pragma unroll
        for (int ai = 0; ai < 2; ++ai)
#pragma unroll
            for (int m = 0; m < 4; ++m) { const int ro = ai * HALF + m * 16;
                f32x4 av[2];
                f32x4 s0[2], s1[2];
                const bool ovr = smp && t < 2;
                if (ovr) { const int bs = (ro + wr * 64 + fr) >> 3; const float* sp = state + ((size_t)bs * 2 + 1) * FFN + f0; s1[0] = *(const f32x4*)sp; s1[1] = *(const f32x4*)(sp + 4);
                    s0[0] = s1[0]; s0[1] = s1[1];
                    if (t == 0) { s0[0] = *(const f32x4*)(sp - FFN); s0[1] = *(const f32x4*)(sp - FFN + 4); } }
#pragma unroll
                for (int n = 0; n < 2; ++n) { const f32x4 g = acc[ai][0][m][n], up = acc[ai][1][m][n]; f32x4 p1, p2;
#pragma unroll
                    for (int e = 0; e < 4; ++e) {
                        if (m == 0) { p1[e] = dpp_shr1(0.f, g[e]); p2[e] = dpp_shr2(0.f, g[e]); }
                        else { const float gp = acc[ai][0][m > 0 ? m - 1 : 0][n][e]; p1[e] = dpp_shr1(dpp_ror1(gp), g[e]); p2[e] = dpp_shr2(dpp_ror2(gp), g[e]); } }
                    if (ovr) { p2 = s0[n]; if (t == 0) p1 = s1[n]; }
                    const f32x4 c = w0[n] * p2 + w1[n] * p1 + w2[n] * g + bb[n];
                    av[n] = gelu4(c) * up; }
                if (smp || m > 0 || fr >= 2) *(u32x4*)(ab + (size_t)ro * FFN) = pack8(av[0], av[1]);
                if (smp) {
                    if (t >= 6) { const int bs = (ro + wr * 64 + fr) >> 3; float* d = out_sc + ((size_t)bs * 2 + (t - 6)) * FFN + f0; *(f32x4*)d = acc[ai][0][m][0]; *(f32x4*)(d + 4) = acc[ai][0][m][1]; }
                } else {
                    const int j64 = u.pm * 4 + ai * 2 + wr;
                    if (m == 0 && fr < 2) { float* hg = halo + ((size_t)j64 * 6 + fr) * FFN + f0; float* hu = hg + 2 * FFN;
                        *(f32x4*)hg = acc[ai][0][m][0]; *(f32x4*)(hg + 4) = acc[ai][0][m][1]; *(f32x4*)hu = acc[ai][1][m][0]; *(f32x4*)(hu + 4) = acc[ai][1][m][1]; }
                    if (m == 3 && fr >= 14) { float* hg = halo + ((size_t)j64 * 6 + 4 + (fr - 14)) * FFN + f0; *(f32x4*)hg = acc[ai][0][m][0]; *(f32x4*)(hg + 4) = acc[ai][0][m][1];
                        if ((u.pm & 7) == 7 && ai == 1 && wr == 1) { float* d = out_pc + ((size_t)(u.pm >> 3) * 2 + (fr - 14)) * FFN + f0; *(f32x4*)d = acc[ai][0][m][0]; *(f32x4*)(d + 4) = acc[ai][0][m][1]; } }
                }
                asm volatile("" ::: "memory"); }
    }
};

template <class Epi, class Sched, bool ALIGN_EPI = false, bool SP2 = false>
__device__ __forceinline__ void gemm_phase(PG8_LAS unsigned char* lds, const Gemm g, const Sched& S, const Epi& E, int wave_in) {
    int wv_l = wave_in; asm volatile("" : "+s"(wv_l)); int ln_l; asm volatile("v_mbcnt_lo_u32_b32 %0, -1, 0\n\tv_mbcnt_hi_u32_b32 %0, -1, %0" : "=v"(ln_l)); const int tid_l = wv_l * 64 + ln_l;
    const int tid = tid_l, wid = __builtin_amdgcn_readfirstlane(tid >> 6), lane = tid & 63, wr = wid >> 2, wc = wid & 3, fr = lane & 15, fq = lane >> 4;
    const int K = g.K, nt = K / BK;
    unsigned voffA[2], voffB[2];
#pragma unroll
    for (int i = 0; i < 2; ++i) { int R, C; stage_rc(tid * 16 + i * 8192, R, C); const int Rb = Epi::PERM ? ((R & ~31) + perm32(R & 31)) : R;
        voffA[i] = (unsigned)(R * K + C) * 2u; voffB[i] = (unsigned)(Rb * K + C) * 2u; }
    const size_t kstep = (size_t)(BK * 2);
    const size_t hstep = (size_t)HALF * K * 2;
    const size_t tstep = 2 * hstep;
    const unsigned ldsw = (unsigned)wid * 1024u;
    const int aoff = lds_byte(wr * 64 + fr, fq * 8), boff = lds_byte(wc * 32 + fr, fq * 8);
#define PG8_SA(b, h) (((b) * 2 + (h)) * HTB)
#define PG8_SB(b, h) ((4 + (b) * 2 + (h)) * HTB)
#define PG8_STAGE(bufoff, gbase, voff) do { _Pragma("unroll") for (int _i = 0; _i < 2; ++_i) \
        __builtin_amdgcn_global_load_lds((const unsigned*)((const char*)(gbase) + (voff)[_i]), (PG8_LAS unsigned*)(lds + (bufoff) + ldsw + _i * 8192), 16, 0, 0); } while (0)
#define PG8_LDA(dst, b, h) do { _Pragma("unroll") for (int m = 0; m < 4; ++m) _Pragma("unroll") for (int k = 0; k < 2; ++k) dst[m][k] = *(const PG8_LAS bf16x8*)(lds + PG8_SA(b, h) + aoff + m * 2048 + k * 1024); } while (0)
#define PG8_LDB(dst, b, h) do { _Pragma("unroll") for (int n = 0; n < 2; ++n) _Pragma("unroll") for (int k = 0; k < 2; ++k) dst[n][k] = *(const PG8_LAS bf16x8*)(lds + PG8_SB(b, h) + boff + n * 2048 + k * 1024); } while (0)
#define PG8_MMA(ai, bj, At, Bt) do { __builtin_amdgcn_s_setprio(1); _Pragma("unroll") for (int m = 0; m < 4; ++m) _Pragma("unroll") for (int n = 0; n < 2; ++n) _Pragma("unroll") for (int k = 0; k < 2; ++k) \
        acc[ai][bj][m][n] = __builtin_amdgcn_mfma_f32_16x16x32_bf16(Bt[n][k], At[m][k], acc[ai][bj][m][n], 0, 0, 0); __builtin_amdgcn_s_setprio(0); } while (0)
#define PG8_WAIT_V(n) asm volatile("s_waitcnt vmcnt(" #n ")" ::: "memory")
#define PG8_WAIT_L(n) asm volatile("s_waitcnt lgkmcnt(" #n ")" ::: "memory")
#define PG8_BAR __builtin_amdgcn_s_barrier()
#define PG8_SCHED __builtin_amdgcn_sched_barrier(0)
    Unit cur, nxt; int ui = 0;
    if (!S.next(0, cur)) return;
    f32x4 acc[2][2][4][2];
#pragma unroll
    for (int a = 0; a < 2; ++a)
#pragma unroll
        for (int b = 0; b < 2; ++b)
#pragma unroll
            for (int m = 0; m < 4; ++m)
#pragma unroll
                for (int n = 0; n < 2; ++n) acc[a][b][m][n] = (f32x4){0.f, 0.f, 0.f, 0.f};
    bf16x8 At[4][2], B0[2][2], B1[2][2];
    const char* cA = (const char*)g.A + (size_t)cur.pm * tstep; const char* cB = (const char*)g.Bt + (size_t)cur.pn * tstep;
    S.a_ready(cur);
    if constexpr (SP2) {
        PG8_STAGE(PG8_SB(0, 0), cB, voffB); PG8_STAGE(PG8_SB(0, 1), cB + hstep, voffB); PG8_STAGE(PG8_SA(0, 0), cA, voffA); PG8_STAGE(PG8_SA(0, 1), cA + hstep, voffA);
        if (wr == 1) PG8_BAR;
        PG8_WAIT_V(2); PG8_BAR;
        PG8_STAGE(PG8_SB(1, 0), cB + kstep, voffB); PG8_STAGE(PG8_SA(1, 0), cA + kstep, voffA); PG8_STAGE(PG8_SB(1, 1), cB + hstep + kstep, voffB);
        PG8_WAIT_V(6); PG8_BAR;
    } else {
        PG8_STAGE(PG8_SB(0, 0), cB, voffB); PG8_STAGE(PG8_SA(0, 0), cA, voffA); PG8_STAGE(PG8_SB(0, 1), cB + hstep, voffB); PG8_STAGE(PG8_SA(0, 1), cA + hstep, voffA);
        if (wr == 1) PG8_BAR;
        PG8_WAIT_V(4); PG8_BAR;
        PG8_STAGE(PG8_SB(1, 0), cB + kstep, voffB); PG8_STAGE(PG8_SA(1, 0), cA + kstep, voffA); PG8_STAGE(PG8_SB(1, 1), cB + hstep + kstep, voffB);
        PG8_WAIT_V(6); PG8_BAR;
    }
    for (;;) {
        const bool has_next = S.next(ui + 1, nxt);
        const char* nA = has_next ? (const char*)g.A + (size_t)nxt.pm * tstep : cA; const char* nB = has_next ? (const char*)g.Bt + (size_t)nxt.pn * tstep : cB;
        for (int t = 0; t < nt; t += 2) {
            const bool last = (t == nt - 2);
            const char* a1 = cA + (size_t)(t + 1) * kstep;
            const char* a2 = last ? nA : cA + (size_t)(t + 2) * kstep; const char* b2 = last ? nB : cB + (size_t)(t + 2) * kstep;
            const char* a3 = a2 + kstep; const char* b3 = b2 + kstep;
            if (last && has_next) S.a_ready(nxt);
            if constexpr (SP2) {
            PG8_LDB(B0, 0, 0); PG8_LDB(B1, 0, 1); PG8_SCHED; PG8_LDA(At, 0, 0); PG8_STAGE(PG8_SA(1, 1), a1 + hstep, voffA);
            PG8_WAIT_V(8); PG8_WAIT_L(0); PG8_BAR; PG8_MMA(0, 0, At, B0); PG8_MMA(0, 1, At, B1); PG8_BAR; PG8_SCHED;
            PG8_LDA(At, 0, 1); PG8_STAGE(PG8_SB(0, 0), b2, voffB); PG8_STAGE(PG8_SB(0, 1), b2 + hstep, voffB); PG8_STAGE(PG8_SA(0, 0), a2, voffA);
            PG8_WAIT_V(8); PG8_WAIT_L(0); PG8_BAR; PG8_MMA(1, 0, At, B0); PG8_MMA(1, 1, At, B1); PG8_BAR; PG8_SCHED;
            PG8_LDB(B0, 1, 0); PG8_LDB(B1, 1, 1); PG8_SCHED; PG8_LDA(At, 1, 0); PG8_STAGE(PG8_SA(0, 1), a2 + hstep, voffA);
            PG8_WAIT_V(8); PG8_WAIT_L(0); PG8_BAR; PG8_MMA(0, 0, At, B0); PG8_MMA(0, 1, At, B1); PG8_BAR; PG8_SCHED;
            PG8_LDA(At, 1, 1); PG8_STAGE(PG8_SB(1, 0), b3, voffB); PG8_STAGE(PG8_SB(1, 1), b3 + hstep, voffB); PG8_STAGE(PG8_SA(1, 0), a3, voffA);
            PG8_WAIT_V(8); PG8_WAIT_L(0); PG8_BAR; PG8_MMA(1, 0, At, B0); PG8_MMA(1, 1, At, B1); PG8_BAR; PG8_SCHED;
            } else {
            PG8_LDB(B0, 0, 0); PG8_SCHED; PG8_LDA(At, 0, 0); PG8_STAGE(PG8_SA(1, 1), a1 + hstep, voffA);
            PG8_WAIT_L(8); PG8_BAR; PG8_WAIT_L(0); PG8_MMA(0, 0, At, B0); PG8_BAR; PG8_SCHED;
            PG8_LDB(B1, 0, 1); PG8_STAGE(PG8_SB(0, 0), b2, voffB);
            PG8_BAR; PG8_WAIT_L(0); PG8_MMA(0, 1, At, B1); PG8_BAR;
            PG8_LDA(At, 0, 1); PG8_STAGE(PG8_SA(0, 0), a2, voffA);
            PG8_BAR; PG8_WAIT_L(0); PG8_MMA(1, 0, At, B0); PG8_BAR; PG8_SCHED;
            PG8_STAGE(PG8_SB(0, 1), b2 + hstep, voffB);
            PG8_WAIT_V(6); PG8_BAR; PG8_MMA(1, 1, At, B1); PG8_BAR;
            PG8_LDB(B0, 1, 0); PG8_SCHED; PG8_LDA(At, 1, 0); PG8_STAGE(PG8_SA(0, 1), a2 + hstep, voffA);
            PG8_WAIT_L(8); PG8_BAR; PG8_WAIT_L(0); PG8_MMA(0, 0, At, B0); PG8_BAR; PG8_SCHED;
            PG8_LDB(B1, 1, 1); PG8_STAGE(PG8_SB(1, 0), b3, voffB);
            PG8_BAR; PG8_WAIT_L(0); PG8_MMA(0, 1, At, B1); PG8_BAR;
            PG8_LDA(At, 1, 1); PG8_STAGE(PG8_SA(1, 0), a3, voffA);
            PG8_BAR; PG8_WAIT_L(0); PG8_MMA(1, 0, At, B0); PG8_BAR; PG8_SCHED;
            PG8_STAGE(PG8_SB(1, 1), b3 + hstep, voffB);
            PG8_WAIT_V(6); PG8_BAR; PG8_MMA(1, 1, At, B1); PG8_BAR;
            }
        }
        if constexpr (ALIGN_EPI) { if (wr == 0) PG8_BAR; }
        if constexpr (!Epi::AFTER_DRAIN) { E(acc, cur, wr, wc, fr, fq); S.done(cur); }
        if (!has_next) break;
#pragma unroll
        for (int a = 0; a < 2; ++a)
#pragma unroll
            for (int b = 0; b < 2; ++b)
#pragma unroll
                for (int m = 0; m < 4; ++m)
#pragma unroll
                    for (int n = 0; n < 2; ++n) acc[a][b][m][n] = (f32x4){0.f, 0.f, 0.f, 0.f};
        cur = nxt; cA = nA; cB = nB; ++ui;
        if constexpr (ALIGN_EPI) { if (wr == 1) PG8_BAR; }
    }
    PG8_WAIT_V(0);
    if constexpr (!ALIGN_EPI) { if (wr == 0) PG8_BAR; }
    PG8_BAR;
    if constexpr (Epi::AFTER_DRAIN) { E.fused(acc, cur, wr, wc, fr, fq, lds, wid, lane); S.done(cur); }
#undef PG8_SA
#undef PG8_SB
#undef PG8_STAGE
#undef PG8_LDA
#undef PG8_LDB
#undef PG8_MMA
#undef PG8_WAIT_V
#undef PG8_WAIT_L
#undef PG8_BAR
#undef PG8_SCHED
}
}
#ifndef SKIP_MASK
#define SKIP_MASK 0
#endif
#define SK(b) (((SKIP_MASK) >> (b)) & 1)
#ifndef PG8_SP2
#define PG8_SP2 true
#endif
#ifndef PG8_ALIGN
#define PG8_ALIGN true
#endif
constexpr int NWAVES = 8;
constexpr int DM = 4096, NPR = 8192, NSM = 256, MT = NPR + NSM, SEQL = 2048, NBATCH = 4, DBATCH = 32, DSEQ = 8;
constexpr int QCOLS = 2048, KVCOLS = 256, GMW = 2048, INC = 6656, FFN = 11008, NGU = 2 * FFN;
constexpr int COL_K = 2048, COL_V = 2304, COL_U = 2560, COL_GV = 4608;
constexpr int NLAYER = 2;
constexpr float EPS = 1e-6f;
constexpr float LOG2E = 1.4426950408889634f;
constexpr size_t O_YP = 0, O_YS = 33554432, O_PK = 34603008, O_PV = 34865152, O_PC = 35127296, O_SK = 35303424, O_SV = 35434496, O_SC = 35565568, O_SG = 36974592, O_END = 38023168;
constexpr size_t MiB = 1u << 20;
constexpr size_t WS_CTL = 0, CTL_ZERO_BYTES = 1 * MiB;
constexpr size_t WL_IN = 0, WL_OUT = 52 * MiB, WL_GU = 84 * MiB, WL_DN = 256 * MiB, WL_STRIDE = 342 * MiB;
constexpr size_t WS_W = 1 * MiB;
constexpr size_t WS_TRIL = WS_W + 2 * WL_STRIDE;
constexpr size_t WS_H = WS_TRIL + 1 * MiB;
constexpr size_t WS_R1 = WS_H + 66 * MiB;
constexpr size_t WS_Z = WS_R1, WS_MIX = WS_R1 + 108 * MiB, WS_A = WS_R1;
constexpr size_t WS_MF = WS_R1 + 178 * MiB;
constexpr size_t WS_SSQ = WS_MF + 66 * MiB;
constexpr size_t WS_HALO = WS_SSQ + 2 * MiB;
constexpr size_t WS_END = WS_HALO + 33 * MiB;
static_assert((size_t)INC * DM * 2 <= 52 * MiB && (size_t)DM * DM * 2 <= 32 * MiB && (size_t)NGU * DM * 2 <= 172 * MiB && (size_t)DM * FFN * 2 <= 86 * MiB, "weight map");
static_assert((size_t)MT * INC * 2 <= 108 * MiB && (size_t)MT * DM * 2 <= 66 * MiB && (size_t)MT * FFN * 2 <= 178 * MiB && (size_t)128 * 6 * FFN * 4 <= 33 * MiB, "activation map");
constexpr int CW_BAR = 4096;
constexpr int RING_OFF = 0, RING_BYTES = 131072;
constexpr int LDSCTL_OFF = RING_BYTES, MISC_OFF = LDSCTL_OFF + 320;
constexpr int LDS_BYTES = 147456;
#define GAS __attribute__((address_space(1)))
#define LAS __attribute__((address_space(3)))
typedef unsigned short bf16;
typedef unsigned v4u __attribute__((ext_vector_type(4)));
typedef float f32x4 __attribute__((ext_vector_type(4)));
typedef short bf16x8 __attribute__((ext_vector_type(8)));
typedef GAS unsigned gu32;
typedef GAS unsigned long long gu64;
#define RLX_AGENT __ATOMIC_RELAXED, __HIP_MEMORY_SCOPE_AGENT
#define LDS_WAIT() asm volatile("s_waitcnt lgkmcnt(0)" ::: "memory")
#define VM_WAIT() asm volatile("s_waitcnt vmcnt(0)" ::: "memory")
__device__ __forceinline__ unsigned long long rt() { return __builtin_amdgcn_s_memrealtime(); }
__device__ __forceinline__ unsigned f2bf(float f) { unsigned u = __builtin_bit_cast(unsigned, f); return (u + 0x7fffu + ((u >> 16) & 1u)) >> 16; }
__device__ __forceinline__ unsigned pk2(float lo, float hi) { return f2bf(lo) | (f2bf(hi) << 16); }

#define XB_TMO      128
#define XB_XCNT(j)  (256  + 64 * (j))
#define XB_XSUB(j)  (1280 + 64 * (j))
#define XB_XGEN(j)  (2304 + 64 * (j))
#define XB_TOP      3328
#define XB_TOPGEN   3392
#define XCD_BAR_WORDS 3456
#define XB_SPIN_CAP (1u << 18)

__device__ __forceinline__ unsigned xb_ld(unsigned* p)              { return __hip_atomic_load(p, __ATOMIC_RELAXED, __HIP_MEMORY_SCOPE_AGENT); }
__device__ __forceinline__ unsigned xb_add(unsigned* p, unsigned v) { return __hip_atomic_fetch_add(p, v, __ATOMIC_RELAXED, __HIP_MEMORY_SCOPE_AGENT); }
__device__ __forceinline__ unsigned xb_xcc_id() { return (unsigned)__builtin_amdgcn_s_getreg((3 << 11) | 20) & 0xFu; }
#define XB_SPIN(cond, bar) do { unsigned _sp = 0; while (cond) { __builtin_amdgcn_s_sleep(1); \
    if ((++_sp & 255u) == 0u) { if (xb_ld(&(bar)[XB_TMO])) break; if (_sp > XB_SPIN_CAP) { atomicAdd(&(bar)[XB_TMO], 1u); break; } } } } while (0)

struct XcdBarrier {
    unsigned* bar; unsigned x;
    volatile LAS unsigned* st;
};

__device__ __forceinline__ XcdBarrier xcd_barrier_post(unsigned* bar, volatile LAS unsigned* st) {
    XcdBarrier b; b.bar = bar; b.x = xb_xcc_id(); b.st = st;
    if (threadIdx.x == 0) (void)xb_add(&bar[XB_XCNT(b.x)], 1u);
    return b;
}
__device__ __forceinline__ void xcd_barrier_complete(unsigned* bar, unsigned x, unsigned& nloc, unsigned& nx) {
    const unsigned G = gridDim.x * gridDim.y * gridDim.z;
    unsigned sum, cnt, mine, sp = 0u;
    for (;;) {
        sum = 0u; cnt = 0u; mine = 0u;
#pragma unroll
        for (unsigned j = 0; j < 16; ++j) { const unsigned c = xb_ld(&bar[XB_XCNT(j)]); sum += c; cnt += (c > 0u) ? 1u : 0u; mine = (j == x) ? c : mine; }
        if (sum == G) break;
        __builtin_amdgcn_s_sleep(1);
        if ((++sp & 255u) == 0u) { if (xb_ld(&bar[XB_TMO])) break; if (sp > XB_SPIN_CAP) { atomicAdd(&bar[XB_TMO], 1u); break; } }
    }
    nloc = mine > 0u ? mine : 1u; nx = cnt > 0u ? cnt : 1u;
}

__device__ __forceinline__ void xcd_barrier(const XcdBarrier& b) {
    asm volatile("s_waitcnt vmcnt(0)" ::: "memory");
    __syncthreads();
    if (threadIdx.x == 0) {
        unsigned* bar = b.bar;
        __builtin_amdgcn_s_waitcnt(0);
        unsigned bx_ = b.x; asm volatile("" : "+s"(bx_));
        unsigned nloc = b.st[0], nx = b.st[1];
        if (nloc == 0u) { xcd_barrier_complete(bar, bx_, nloc, nx); b.st[0] = nloc; b.st[1] = nx; }
        const unsigned old = xb_add(&bar[XB_XSUB(bx_)], 1u);
        const unsigned gen = old / nloc;
        if (old + 1u == (gen + 1u) * nloc) {
            __builtin_amdgcn_fence(__ATOMIC_RELEASE, "agent");
            asm volatile("s_waitcnt vmcnt(0)" ::: "memory");
            const unsigned og = xb_add(&bar[XB_TOP], 1u);
            const unsigned tg = og / nx;
            if (og + 1u == (tg + 1u) * nx) xb_add(&bar[XB_TOPGEN], 1u);
            else XB_SPIN(xb_ld(&bar[XB_TOPGEN]) == tg, bar);
            __builtin_amdgcn_fence(__ATOMIC_ACQUIRE, "agent");
            xb_add(&bar[XB_XGEN(bx_)], 1u);
            asm volatile("s_waitcnt vmcnt(0)" ::: "memory");
        } else {
            XB_SPIN(xb_ld(&bar[XB_XGEN(bx_)]) == gen, bar);
            __builtin_amdgcn_fence(__ATOMIC_ACQUIRE, "agent");
            asm volatile("s_waitcnt vmcnt(0)" ::: "memory");
        }
    }
    __syncthreads();
}
typedef float f32x16 __attribute__((ext_vector_type(16)));
typedef unsigned v2u __attribute__((ext_vector_type(2)));
__device__ __forceinline__ unsigned cvtpk(float lo, float hi) { return pg8::cvt_pk_bf16(lo, hi); }
__device__ __forceinline__ float bflo(unsigned w) { return __uint_as_float(w << 16); }
__device__ __forceinline__ float bfhi(unsigned w) { return __uint_as_float(w & 0xffff0000u); }
__device__ __forceinline__ float wave_sum(float v) {
#pragma unroll
    for (int o = 1; o < 64; o <<= 1) v += __shfl_xor(v, o);
    return v;
}
__device__ __forceinline__ int crow(int r, int hi) { return (r & 3) + 8 * (r >> 2) + 4 * hi; }

__device__ __forceinline__ void cvt_item(const float* W, int K, int N, bf16* WT, int mode  , LAS unsigned char* scr, int item, int lane) {
    const int nblk = N >> 6, kb = item / nblk, nb = item - kb * nblk, k0 = kb << 6, n0 = nb << 6;
    const int kq = lane >> 4, nq = lane & 15;
#pragma unroll 4
    for (int it = 0; it < 16; ++it) { const int k = 4 * it + kq;
        const f32x4 v = *(const GAS f32x4*)(W + (size_t)(k0 + k) * N + n0 + 4 * nq);
        const unsigned p01 = cvtpk(v[0], v[1]), p23 = cvtpk(v[2], v[3]);
        LAS unsigned short* d = (LAS unsigned short*)(scr + (4 * nq) * 144 + k * 2);
        d[0] = (unsigned short)(p01 & 0xffffu); d[72] = (unsigned short)(p01 >> 16); d[144] = (unsigned short)(p23 & 0xffffu); d[216] = (unsigned short)(p23 >> 16); }
    LDS_WAIT(); asm volatile("" ::: "memory");
    const int rbase = (mode == 0) ? n0 : (2 * (n0 & ~127) + (n0 & 127) + (mode == 2 ? 128 : 0));
#pragma unroll
    for (int jj = 0; jj < 8; ++jj) { const int n = 8 * jj + (lane >> 3), kc = lane & 7;
        const v4u o = *(const LAS v4u*)(scr + n * 144 + kc * 16);
        *(GAS v4u*)(WT + (size_t)(rbase + n) * K + k0 + 8 * kc) = o; }
    LDS_WAIT(); asm volatile("" ::: "memory");
}

template <bool HAS_MF>
__device__ __forceinline__ void norm_rows(const bool HAS_NEXT, const float* xp_in, const float* xs_in, const bf16* mf, const float* gpost, float* xout, const float* gnext, bf16* h, int gw, int ngw, int lane_in) {
#pragma unroll 1
    for (int row = gw; row < MT; row += ngw) {
        int lane = lane_in; asm volatile("" : "+v"(lane));
        const float* xr = (row < NPR) ? xp_in + (size_t)row * DM : xs_in + (size_t)(row - NPR) * DM;
        f32x4 x[16];
#pragma unroll
        for (int j = 0; j < 16; ++j) x[j] = ((const GAS f32x4*)xr)[lane + 64 * j];
        if (HAS_MF) {
            v2u mm[16]; float ss = 0.f;
#pragma unroll
            for (int j = 0; j < 16; ++j) mm[j] = ((const GAS v2u*)(mf + (size_t)row * DM))[lane + 64 * j];
            asm volatile("" ::: "memory");
#pragma unroll
            for (int j = 0; j < 16; ++j) { const float a = bflo(mm[j].x), b = bfhi(mm[j].x), c = bflo(mm[j].y), d = bfhi(mm[j].y); ss += (a * a + b * b) + (c * c + d * d); }
            const float r1 = 1.0f / sqrtf(wave_sum(ss) * (1.0f / DM) + EPS);
#pragma unroll
            for (int jb = 0; jb < 4; ++jb) { f32x4 g[4];
#pragma unroll
                for (int jj = 0; jj < 4; ++jj) g[jj] = ((const GAS f32x4*)gpost)[lane + 64 * (4 * jb + jj)];
#pragma unroll
                for (int jj = 0; jj < 4; ++jj) { const int j = 4 * jb + jj;
                    x[j][0] += bflo(mm[j].x) * r1 * g[jj][0]; x[j][1] += bfhi(mm[j].x) * r1 * g[jj][1]; x[j][2] += bflo(mm[j].y) * r1 * g[jj][2]; x[j][3] += bfhi(mm[j].y) * r1 * g[jj][3];
                    ((GAS f32x4*)(xout + (size_t)row * DM))[lane + 64 * j] = x[j]; }
                asm volatile("" ::: "memory"); }
        }
        if (HAS_NEXT) {
            float s2 = 0.f;
#pragma unroll
            for (int j = 0; j < 16; ++j) s2 += (x[j][0] * x[j][0] + x[j][1] * x[j][1]) + (x[j][2] * x[j][2] + x[j][3] * x[j][3]);
            const float r2 = 1.0f / sqrtf(wave_sum(s2) * (1.0f / DM) + EPS);
#pragma unroll
            for (int jb = 0; jb < 4; ++jb) { f32x4 g[4];
#pragma unroll
                for (int jj = 0; jj < 4; ++jj) g[jj] = ((const GAS f32x4*)gnext)[lane + 64 * (4 * jb + jj)];
#pragma unroll
                for (int jj = 0; jj < 4; ++jj) { const int j = 4 * jb + jj;
                    v2u o; o.x = cvtpk(x[j][0] * r2 * g[jj][0], x[j][1] * r2 * g[jj][1]); o.y = cvtpk(x[j][2] * r2 * g[jj][2], x[j][3] * r2 * g[jj][3]);
                    ((GAS v2u*)(h + (size_t)row * DM))[lane + 64 * j] = o; }
                asm volatile("" ::: "memory"); }
        }
    }
}

constexpr int KS_STRIDE = 144, VT_STRIDE = 528, ATT_VT_OFF = 256 * KS_STRIDE;
#define MFMA32(a, b, c) __builtin_amdgcn_mfma_f32_32x32x16_bf16((a), (b), (c), 0, 0, 0)
__device__ __forceinline__ void attn_item(const LAS unsigned char* Ks, const LAS unsigned char* Vt, const bf16* qptr, int qi, float sink, bf16* optr, int kb0, bool n0, int lane) {
    const int r32 = lane & 31, hi = lane >> 5;
    bf16x8 qf[4];
#pragma unroll
    for (int ks = 0; ks < 4; ++ks) qf[ks] = *(const GAS bf16x8*)(qptr + ks * 16 + hi * 8);
    f32x16 s[5];
#pragma unroll
    for (int kk = 0; kk < 5; ++kk) { f32x16 a = {};
#pragma unroll
        for (int ks = 0; ks < 4; ++ks) { const bf16x8 kf = *(const LAS bf16x8*)(Ks + (32 * (kb0 + kk) + r32) * KS_STRIDE + (16 * ks + 8 * hi) * 2); a = MFMA32(kf, qf[ks], a); }
        s[kk] = a; }
    float mx = sink;
#pragma unroll
    for (int kk = 0; kk < 5; ++kk)
#pragma unroll
        for (int r = 0; r < 16; ++r) { const int j = 32 * (kb0 + kk) + crow(r, hi); const bool ok = (j > qi) && (j <= qi + 128) && (!n0 || j >= 128);
            const float v = ok ? s[kk][r] : -INFINITY; s[kk][r] = v; mx = fmaxf(mx, v); }
    mx = fmaxf(mx, __shfl_xor(mx, 32));
    float l = 0.f;
#pragma unroll
    for (int kk = 0; kk < 5; ++kk)
#pragma unroll
        for (int r = 0; r < 16; ++r) { const float p = __builtin_amdgcn_exp2f((s[kk][r] - mx) * LOG2E); s[kk][r] = p; l += p; }
    l += __shfl_xor(l, 32);
    l += __builtin_amdgcn_exp2f((sink - mx) * LOG2E);
    f32x16 o[2] = {{}, {}};
#pragma unroll
    for (int kk = 0; kk < 5; ++kk)
#pragma unroll
        for (int si = 0; si < 2; ++si) { v4u pw; pw.x = cvtpk(s[kk][8 * si + 0], s[kk][8 * si + 1]); pw.y = cvtpk(s[kk][8 * si + 2], s[kk][8 * si + 3]); pw.z = cvtpk(s[kk][8 * si + 4], s[kk][8 * si + 5]); pw.w = cvtpk(s[kk][8 * si + 6], s[kk][8 * si + 7]);
            const bf16x8 pf = __builtin_bit_cast(bf16x8, pw);
#pragma unroll
            for (int db = 0; db < 2; ++db) { const LAS unsigned char* vp = Vt + (32 * db + r32) * VT_STRIDE + (32 * (kb0 + kk) + 16 * si + 4 * hi) * 2;
                const v2u lo = *(const LAS v2u*)vp, hh = *(const LAS v2u*)(vp + 16);
                v4u vw; vw.x = lo.x; vw.y = lo.y; vw.z = hh.x; vw.w = hh.y;
                o[db] = MFMA32(__builtin_bit_cast(bf16x8, vw), pf, o[db]); } }
    const float inv = 1.0f / l;
#pragma unroll
    for (int db = 0; db < 2; ++db)
#pragma unroll
        for (int g4 = 0; g4 < 4; ++g4) { v2u w; w.x = cvtpk(o[db][4 * g4 + 0] * inv, o[db][4 * g4 + 1] * inv); w.y = cvtpk(o[db][4 * g4 + 2] * inv, o[db][4 * g4 + 3] * inv);
            *(GAS v2u*)(optr + 32 * db + 8 * g4 + 4 * hi) = w; }
}
__device__ __forceinline__ void vt_scatter(LAS unsigned char* Vt, int part, int key, v4u vv) {
#pragma unroll
    for (int e = 0; e < 8; ++e) { const unsigned w = vv[e >> 1]; *(LAS unsigned short*)(Vt + (part * 8 + e) * VT_STRIDE + key * 2) = (unsigned short)((e & 1) ? (w >> 16) : (w & 0xffffu)); }
}
__device__ __forceinline__ void attn_unit_prompt(LAS unsigned char* lds, const bf16* Z, bf16* MIX, const float* sinks, int unit, int tid, int wave, int lane) {
    const int kvh = unit & 3, n = (unit >> 2) & 15, b = unit >> 6;
    LAS unsigned char* Ks = lds; LAS unsigned char* Vt = lds + ATT_VT_OFF;
    const int keyrow0 = b * SEQL + 128 * (n - 1); const bool n0 = (n == 0);
#pragma unroll
    for (int i = 0; i < 4; ++i) { const int c = tid + 512 * i, key = c >> 3, part = c & 7;
        v4u kv = {0u, 0u, 0u, 0u}, vv = {0u, 0u, 0u, 0u};
        if (!(n0 && key < 128)) { const bf16* zr = Z + (size_t)(keyrow0 + key) * INC + kvh * 64 + part * 8; kv = *(const GAS v4u*)(zr + COL_K); vv = *(const GAS v4u*)(zr + COL_V); }
        *(LAS v4u*)(Ks + key * KS_STRIDE + part * 16) = kv; vt_scatter(Vt, part, key, vv); }
    __syncthreads();
    const int head = kvh * 8 + wave; const float sink = sinks[head];
#pragma unroll 1
    for (int qb = 0; qb < 4; ++qb) { const int qi = 32 * qb + (lane & 31); const size_t row = (size_t)b * SEQL + 128 * n + qi;
        attn_item(Ks, Vt, Z + row * INC + head * 64, qi, sink, MIX + row * DM + head * 64, qb, n0, lane); }
    __syncthreads();
}
__device__ __forceinline__ void attn_unit_sample(LAS unsigned char* lds, const bf16* Z, bf16* MIX, const float* sinks, const float* stk, const float* stv  , int unit, int tid, int wave, int lane) {
    const int kvh = unit & 3, bs = unit >> 2;
    LAS unsigned char* Ks = lds; LAS unsigned char* Vt = lds + ATT_VT_OFF;
    for (int c = tid; c < 160 * 8; c += 512) { const int key = c >> 3, part = c & 7;
        v4u kv = {0u, 0u, 0u, 0u}, vv = {0u, 0u, 0u, 0u};
        if (key < 128) { const size_t o = (((size_t)bs * 128 + key) * 4 + kvh) * 64 + part * 8;
            const f32x4 k0 = *(const GAS f32x4*)(stk + o), k1 = *(const GAS f32x4*)(stk + o + 4), v0 = *(const GAS f32x4*)(stv + o), v1 = *(const GAS f32x4*)(stv + o + 4);
            kv.x = cvtpk(k0[0], k0[1]); kv.y = cvtpk(k0[2], k0[3]); kv.z = cvtpk(k1[0], k1[1]); kv.w = cvtpk(k1[2], k1[3]);
            vv.x = cvtpk(v0[0], v0[1]); vv.y = cvtpk(v0[2], v0[3]); vv.z = cvtpk(v1[0], v1[1]); vv.w = cvtpk(v1[2], v1[3]); }
        else if (key < 136) { const bf16* zr = Z + (size_t)(NPR + bs * DSEQ + (key - 128)) * INC + kvh * 64 + part * 8; kv = *(const GAS v4u*)(zr + COL_K); vv = *(const GAS v4u*)(zr + COL_V); }
        *(LAS v4u*)(Ks + key * KS_STRIDE + part * 16) = kv; vt_scatter(Vt, part, key, vv); }
    __syncthreads();
    if (wave < 2) { const int q = lane & 31, head = kvh * 8 + wave * 4 + (q >> 3), t = q & 7; const size_t row = (size_t)NPR + bs * DSEQ + t;
        attn_item(Ks, Vt, Z + row * INC + head * 64, t, sinks[head], MIX + row * DM + head * 64, 0, false, lane); }
    __syncthreads();
}
constexpr int VN_STRIDE = 272, GM_RS_OFF = 128 * VN_STRIDE;
__device__ __forceinline__ void gmlp_unit(LAS unsigned char* lds, const bf16* Z, bf16* MIX, const float* ssq, const float* gnorm, const bf16* wtril, const float* gbias, int unit, int tid, int wave, int lane) {
    const int hh = unit & 15, R0 = (unit >> 4) * 128;
    LAS unsigned char* vnT = lds; LAS float* rsl = (LAS float*)(lds + GM_RS_OFF);
    if (tid < 128) { const GAS f32x4* p = (const GAS f32x4*)(ssq + (size_t)(R0 + tid) * 32); float s = 0.f;
#pragma unroll
        for (int i = 0; i < 8; ++i) { const f32x4 v = p[i]; s += (v[0] + v[1]) + (v[2] + v[3]); }
        rsl[tid] = 1.0f / sqrtf(s * (1.0f / GMW) + EPS); }
    __syncthreads();
#pragma unroll
    for (int i = 0; i < 4; ++i) { const int c = tid + 512 * i, s = c >> 4, ep = c & 15;
        const v4u raw = *(const GAS v4u*)(Z + (size_t)(R0 + s) * INC + COL_GV + hh * 128 + ep * 8);
        const float rs = rsl[s]; const f32x4 g0 = *(const GAS f32x4*)(gnorm + hh * 128 + ep * 8), g1 = *(const GAS f32x4*)(gnorm + hh * 128 + ep * 8 + 4);
        const unsigned p0 = cvtpk(bflo(raw.x) * rs * g0[0], bfhi(raw.x) * rs * g0[1]), p1 = cvtpk(bflo(raw.y) * rs * g0[2], bfhi(raw.y) * rs * g0[3]);
        const unsigned p2 = cvtpk(bflo(raw.z) * rs * g1[0], bfhi(raw.z) * rs * g1[1]), p3 = cvtpk(bflo(raw.w) * rs * g1[2], bfhi(raw.w) * rs * g1[3]);
        LAS unsigned short* d = (LAS unsigned short*)(vnT + (ep * 8) * VN_STRIDE + s * 2);
        d[0 * 136] = (unsigned short)(p0 & 0xffffu); d[1 * 136] = (unsigned short)(p0 >> 16); d[2 * 136] = (unsigned short)(p1 & 0xffffu); d[3 * 136] = (unsigned short)(p1 >> 16);
        d[4 * 136] = (unsigned short)(p2 & 0xffffu); d[5 * 136] = (unsigned short)(p2 >> 16); d[6 * 136] = (unsigned short)(p3 & 0xffffu); d[7 * 136] = (unsigned short)(p3 >> 16); }
    __syncthreads();
    const int r32 = lane & 31, hi = lane >> 5, tb = wave >> 1, eb0 = (wave & 1) * 2, t = 32 * tb + r32;
    f32x16 a0 = {}, a1 = {};
    const bf16* wrow = wtril + ((size_t)hh * 128 + t) * 128;
    const int nks = 2 * tb + 2;
#pragma unroll 2
    for (int ks = 0; ks < nks; ++ks) { const bf16x8 wf = *(const GAS bf16x8*)(wrow + 16 * ks + 8 * hi);
        const bf16x8 v0 = *(const LAS bf16x8*)(vnT + (32 * eb0 + r32) * VN_STRIDE + (16 * ks + 8 * hi) * 2), v1 = *(const LAS bf16x8*)(vnT + (32 * (eb0 + 1) + r32) * VN_STRIDE + (16 * ks + 8 * hi) * 2);
        a0 = MFMA32(v0, wf, a0); a1 = MFMA32(v1, wf, a1); }
    const float bias = gbias[hh * 128 + t];
    const bf16* urow = Z + (size_t)(R0 + t) * INC + COL_U + hh * 128; bf16* orow = MIX + (size_t)(R0 + t) * DM + QCOLS + hh * 128;
#pragma unroll
    for (int eb = 0; eb < 2; ++eb)
#pragma unroll
        for (int g4 = 0; g4 < 4; ++g4) { const int e0 = 32 * (eb0 + eb) + 8 * g4 + 4 * hi; const v2u uu = *(const GAS v2u*)(urow + e0);
            const float s0 = (eb ? a1[4 * g4 + 0] : a0[4 * g4 + 0]) + bias, s1 = (eb ? a1[4 * g4 + 1] : a0[4 * g4 + 1]) + bias, s2 = (eb ? a1[4 * g4 + 2] : a0[4 * g4 + 2]) + bias, s3 = (eb ? a1[4 * g4 + 3] : a0[4 * g4 + 3]) + bias;
            v2u w; w.x = cvtpk(bflo(uu.x) * s0, bfhi(uu.x) * s1); w.y = cvtpk(bflo(uu.y) * s2, bfhi(uu.y) * s3);
            *(GAS v2u*)(orow + e0) = w; }
    __syncthreads();
}
__device__ __forceinline__ void gmlp_sample_item(LAS unsigned char* lds, const bf16* Z, bf16* MIX, const float* ssq, const float* gnorm, const float* wsp  , const float* gbias, float* out_sg, int item, int tid) {
    const int bs = item >> 3, part = item & 7;
    LAS float* rsl = (LAS float*)lds;
    if (tid < 8) { const GAS f32x4* p = (const GAS f32x4*)(ssq + (size_t)(NPR + bs * DSEQ + tid) * 32); float s = 0.f;
#pragma unroll
        for (int i = 0; i < 8; ++i) { const f32x4 v = p[i]; s += (v[0] + v[1]) + (v[2] + v[3]); }
        rsl[tid] = 1.0f / sqrtf(s * (1.0f / GMW) + EPS); }
    __syncthreads();
    const int t = tid >> 6, col = part * 256 + (tid & 63) * 4, hh = col >> 7;
    const f32x4 g = *(const GAS f32x4*)(gnorm + col);
    f32x4 acc = {0.f, 0.f, 0.f, 0.f};
    const float* wr = wsp + ((size_t)hh * 128 + t) * 128;
    for (int s = 0; s <= t; ++s) { const size_t row = (size_t)NPR + bs * DSEQ + s; const v2u raw = *(const GAS v2u*)(Z + row * INC + COL_GV + col); const float rs = rsl[s], w = wr[s];
        f32x4 vn; vn[0] = bflo(raw.x) * rs * g[0]; vn[1] = bfhi(raw.x) * rs * g[1]; vn[2] = bflo(raw.y) * rs * g[2]; vn[3] = bfhi(raw.y) * rs * g[3];
        acc += vn * w;
        if (s == t) *(GAS f32x4*)(out_sg + (size_t)(bs * DSEQ + t) * GMW + col) = vn; }
    const float bias = gbias[hh * 128 + t];
    const size_t row = (size_t)NPR + bs * DSEQ + t; const v2u uu = *(const GAS v2u*)(Z + row * INC + COL_U + col);
    v2u w; w.x = cvtpk(bflo(uu.x) * (acc[0] + bias), bfhi(uu.x) * (acc[1] + bias)); w.y = cvtpk(bflo(uu.y) * (acc[2] + bias), bfhi(uu.y) * (acc[3] + bias));
    *(GAS v2u*)(MIX + row * DM + QCOLS + col) = w;
    __syncthreads();
}

struct Args { const float* in[20]; float* out; unsigned char* ws; int ph_lo, ph_hi; };
constexpr int N_PHASES = 1 + 8 * NLAYER;
__global__ void __launch_bounds__(NWAVES * 64, 2) fwd_kernel(Args args) {
    extern __shared__ __attribute__((aligned(16))) unsigned char lds_raw[];
    LAS unsigned char* lds = (LAS unsigned char*)lds_raw;
    volatile LAS unsigned* MISC = (volatile LAS unsigned*)(lds + MISC_OFF);
    constexpr int G = 256;
    const int bx = blockIdx.x; constexpr int NGW = G * NWAVES;
    __builtin_assume(bx >= 0 && bx < G);
    const int wave0 = __builtin_amdgcn_readfirstlane((int)threadIdx.x >> 6);
    unsigned char* ws = args.ws;
    gu32* ctl = (gu32*)(ws + WS_CTL);
    for (int u = threadIdx.x; u < (LDS_BYTES - LDSCTL_OFF) / 4; u += NWAVES * 64) ((LAS unsigned*)(lds + LDSCTL_OFF))[u] = 0u;
    __syncthreads();
    XcdBarrier bar; bar.bar = (unsigned*)(ctl + CW_BAR); bar.x = 0; bar.st = nullptr;
    if (!MK_PER_PHASE) bar = xcd_barrier_post((unsigned*)(ctl + CW_BAR), MISC + 8);
#if MK_PER_PHASE
    const int lo = args.ph_lo, hi = args.ph_hi;
#else
    constexpr int lo = 0, hi = N_PHASES;
#endif
#define IN(k) (lo <= (k) && (k) < hi)
#define PHASE_IDS int wv_p = wave0; asm volatile("" : "+s"(wv_p)); int ln_p; asm volatile("v_mbcnt_lo_u32_b32 %0, -1, 0\n\tv_mbcnt_hi_u32_b32 %0, -1, %0" : "=v"(ln_p)); const int tid = wv_p * 64 + ln_p, lane = tid & 63, wave = __builtin_amdgcn_readfirstlane(tid >> 6), gw = bx * NWAVES + wave; (void)lane; (void)gw; (void)wave; (void)tid
#define SEAM(k) do { if (IN(k) && IN((k) + 1)) xcd_barrier(bar); } while (0)

    const float* x_prompt = args.in[0]; const float* x_sample = args.in[1];
    float* out = args.out;
    bf16* Hb = (bf16*)(ws + WS_H); bf16* Zb = (bf16*)(ws + WS_Z); bf16* MIXb = (bf16*)(ws + WS_MIX); bf16* Ab = (bf16*)(ws + WS_A); bf16* MFb = (bf16*)(ws + WS_MF);
    float* SSQ = (float*)(ws + WS_SSQ); float* HALO = (float*)(ws + WS_HALO); bf16* TRIL = (bf16*)(ws + WS_TRIL);

    if (IN(0) && !SK(0)) { PHASE_IDS;
        LAS unsigned char* scr = lds + RING_OFF + wave * 9216;
        constexpr int I_IN = (DM / 64) * (INC / 64), I_OUT = (DM / 64) * (DM / 64), I_G = (DM / 64) * (FFN / 64), I_DN = (FFN / 64) * (DM / 64);
        constexpr int I_LAYER = I_IN + I_OUT + 2 * I_G + I_DN;
        for (int it = gw; it < NLAYER * I_LAYER; it += NGW) {
            const int l = it / I_LAYER; int r = it - l * I_LAYER;
            unsigned char* wl = ws + WS_W + (size_t)l * WL_STRIDE;
            if (r < I_IN) { cvt_item(args.in[5] + (size_t)l * DM * INC, DM, INC, (bf16*)(wl + WL_IN), 0, scr, r, lane); continue; } r -= I_IN;
            if (r < I_OUT) { cvt_item(args.in[6] + (size_t)l * DM * DM, DM, DM, (bf16*)(wl + WL_OUT), 0, scr, r, lane); continue; } r -= I_OUT;
            if (r < I_G) { cvt_item(args.in[15] + (size_t)l * DM * FFN, DM, FFN, (bf16*)(wl + WL_GU), 1, scr, r, lane); continue; } r -= I_G;
            if (r < I_G) { cvt_item(args.in[16] + (size_t)l * DM * FFN, DM, FFN, (bf16*)(wl + WL_GU), 2, scr, r, lane); continue; } r -= I_G;
            cvt_item(args.in[17] + (size_t)l * FFN * DM, FFN, DM, (bf16*)(wl + WL_DN), 0, scr, r, lane);
        }
        for (int i = bx * 512 + tid; i < NLAYER * 16 * 128 * 128 / 4; i += G * 512) { const f32x4 v = ((const GAS f32x4*)args.in[8])[i]; const int s0 = (i * 4) & 127, t = ((i * 4) >> 7) & 127;
            v2u o; o.x = cvtpk(s0 + 0 <= t ? v[0] : 0.f, s0 + 1 <= t ? v[1] : 0.f); o.y = cvtpk(s0 + 2 <= t ? v[2] : 0.f, s0 + 3 <= t ? v[3] : 0.f); ((GAS v2u*)TRIL)[i] = o; }
        norm_rows<false>(true, x_prompt, x_sample, nullptr, nullptr, nullptr, args.in[11], Hb, gw, NGW, lane);
    }
    SEAM(0);
#pragma unroll 1
    for (int l = 0; l < NLAYER; ++l) {
        const int pb = 1 + 8 * l;
        unsigned char* wl = ws + WS_W + (size_t)l * WL_STRIDE;
        if (IN(pb + 0) && !SK(1)) {
            pg8::Gemm g{Hb, (const bf16*)(wl + WL_IN), MT, INC, DM}; pg8::StaticOrder S; S.init(MT, INC, G, bx);
            pg8::EpiIn E{Zb, SSQ, out + O_PK + (size_t)l * 131072, out + O_PV + (size_t)l * 131072, out + O_SK + (size_t)l * 65536, out + O_SV + (size_t)l * 65536};
            pg8::gemm_phase<pg8::EpiIn, pg8::StaticOrder, PG8_ALIGN, PG8_SP2>(lds + RING_OFF, g, S, E, wave0);
        }
        SEAM(pb + 0);
        if (IN(pb + 1) && !SK(2)) { PHASE_IDS;
            const float* sinks = args.in[7] + l * 32;
            for (int u = bx; u < 256; u += G) attn_unit_prompt(lds, Zb, MIXb, sinks, u, tid, wave, lane);
            const float* gnorm = args.in[10] + l * GMW; const float* gbias = args.in[9] + l * 2048; const bf16* wtril = TRIL + (size_t)l * 16 * 128 * 128;
            for (int i = 0; i < 4; ++i) { const int u = (bx * 4 + i); if (u < 1024) gmlp_unit(lds, Zb, MIXb, SSQ, gnorm, wtril, gbias, u, tid, wave, lane); }
            if (G * 4 < 1024) for (int u = G * 4 + bx; u < 1024; u += G) gmlp_unit(lds, Zb, MIXb, SSQ, gnorm, wtril, gbias, u, tid, wave, lane);
            const float* stk = args.in[2] + (size_t)l * DBATCH * 128 * 256; const float* stv = args.in[3] + (size_t)l * DBATCH * 128 * 256;
            for (int u = bx; u < 128; u += G) attn_unit_sample(lds, Zb, MIXb, sinks, stk, stv, u, tid, wave, lane);
            for (int it = bx; it < 256; it += G) gmlp_sample_item(lds, Zb, MIXb, SSQ, gnorm, args.in[8] + (size_t)l * 16 * 128 * 128, gbias, out + O_SG + (size_t)l * NSM * GMW, it, tid);
        }
        SEAM(pb + 1);
        if (IN(pb + 2) && !SK(3)) {
            pg8::Gemm g{MIXb, (const bf16*)(wl + WL_OUT), MT, DM, DM}; pg8::StaticOrder S; S.init(MT, DM, G, bx);
            pg8::EpiPlain E{MFb, DM};
            pg8::gemm_phase<pg8::EpiPlain, pg8::StaticOrder, PG8_ALIGN, PG8_SP2>(lds + RING_OFF, g, S, E, wave0);
        }
        SEAM(pb + 2);
        if (IN(pb + 3) && !SK(4)) { PHASE_IDS;
            const float* xp = l == 0 ? x_prompt : out + O_YP; const float* xs = l == 0 ? x_sample : out + O_YS;
            norm_rows<true>(true, xp, xs, MFb, args.in[12] + l * DM, out, args.in[13] + l * DM, Hb, gw, NGW, lane);
        }
        SEAM(pb + 3);
        if (IN(pb + 4) && !SK(5)) {
            pg8::Gemm g{Hb, (const bf16*)(wl + WL_GU), MT, NGU, DM}; pg8::StaticOrder S; S.init(MT, NGU, G, bx);
            pg8::EpiGU E{Ab, HALO, args.in[18] + (size_t)l * 3 * FFN, args.in[19] + (size_t)l * FFN, args.in[4] + (size_t)l * DBATCH * 2 * FFN, out + O_PC + (size_t)l * NBATCH * 2 * FFN, out + O_SC + (size_t)l * DBATCH * 2 * FFN};
            pg8::gemm_phase<pg8::EpiGU, pg8::StaticOrder, PG8_ALIGN, PG8_SP2>(lds + RING_OFF, g, S, E, wave0);
        }
        SEAM(pb + 4);
        if (IN(pb + 5) && !SK(6)) { PHASE_IDS;
            const float* cw = args.in[18] + (size_t)l * 3 * FFN; const float* cb = args.in[19] + (size_t)l * FFN;
            for (int i = bx * 512 + tid; i < 128 * (FFN / 4); i += G * 512) { const int j = i / (FFN / 4), f = (i - j * (FFN / 4)) * 4;
                const float* hb = HALO + (size_t)j * 6 * FFN + f;
                const f32x4 g0 = *(const GAS f32x4*)hb, g1 = *(const GAS f32x4*)(hb + FFN), u0 = *(const GAS f32x4*)(hb + 2 * FFN), u1 = *(const GAS f32x4*)(hb + 3 * FFN);
                f32x4 q62 = {0.f, 0.f, 0.f, 0.f}, q63 = q62;
                if ((j & 31) != 0) { q62 = *(const GAS f32x4*)(hb - 2 * FFN); q63 = *(const GAS f32x4*)(hb - FFN); }
                const f32x4 w0 = *(const GAS f32x4*)(cw + f), w1 = *(const GAS f32x4*)(cw + FFN + f), w2 = *(const GAS f32x4*)(cw + 2 * FFN + f), bb = *(const GAS f32x4*)(cb + f);
                const f32x4 c0 = w0 * q62 + w1 * q63 + w2 * g0 + bb, c1 = w0 * q63 + w1 * g0 + w2 * g1 + bb;
                const f32x4 a0 = pg8::gelu4(c0) * u0, a1 = pg8::gelu4(c1) * u1;
                v2u o0, o1; o0.x = cvtpk(a0[0], a0[1]); o0.y = cvtpk(a0[2], a0[3]); o1.x = cvtpk(a1[0], a1[1]); o1.y = cvtpk(a1[2], a1[3]);
                *(GAS v2u*)(Ab + (size_t)(64 * j) * FFN + f) = o0; *(GAS v2u*)(Ab + (size_t)(64 * j + 1) * FFN + f) = o1; }
        }
        SEAM(pb + 5);
        if (IN(pb + 6) && !SK(7)) {
            pg8::Gemm g{Ab, (const bf16*)(wl + WL_DN), MT, DM, FFN}; pg8::StaticOrder S; S.init(MT, DM, G, bx);
            pg8::EpiPlain E{MFb, DM};
            pg8::gemm_phase<pg8::EpiPlain, pg8::StaticOrder, PG8_ALIGN, PG8_SP2>(lds + RING_OFF, g, S, E, wave0);
        }
        SEAM(pb + 6);
        if (IN(pb + 7) && !SK(8)) { PHASE_IDS;
            const bool nxt = (l + 1 < NLAYER);
            norm_rows<true>(nxt, out + O_YP, out + O_YS, MFb, args.in[14] + l * DM, out, args.in[11] + (nxt ? l + 1 : 0) * DM, Hb, gw, NGW, lane);
        }
        if (l + 1 < NLAYER) SEAM(pb + 7);
    }
#undef IN
#undef SEAM
}

extern "C" void kernel_launch(void* const* d_in, const int* in_sizes, int n_in, void* d_out, int out_size, void* d_ws, size_t ws_size, hipStream_t stream) {
    static int grid = 0;
    if (grid == 0) {
        if (n_in != 20 || (size_t)out_size != O_END || ws_size < WS_END) { fprintf(stderr, "kernel_launch: unexpected shapes: n_in %d out %d ws %zu (need %zu)\n", n_in, out_size, ws_size, (size_t)WS_END); grid = -1; return; }
        int dev = 0, cus = 0, per_cu = 0;
        if (hipGetDevice(&dev) != hipSuccess || hipDeviceGetAttribute(&cus, hipDeviceAttributeMultiprocessorCount, dev) != hipSuccess) { grid = -1; return; }
        if (hipFuncSetAttribute((const void*)fwd_kernel, hipFuncAttributeMaxDynamicSharedMemorySize, LDS_BYTES) != hipSuccess) { fprintf(stderr, "kernel_launch: hipFuncSetAttribute failed\n"); grid = -1; return; }
        if (hipOccupancyMaxActiveBlocksPerMultiprocessor(&per_cu, (const void*)fwd_kernel, NWAVES * 64, LDS_BYTES) != hipSuccess || per_cu < 1) fprintf(stderr, "kernel_launch: occupancy query reports %d\n", per_cu);
        (void)hipGetLastError();
        if (cus < 256) { fprintf(stderr, "kernel_launch: built for a 256-CU device, found %d CUs\n", cus); grid = -1; return; }
        grid = 256;
    }
    if (grid < 0) return;
    if (hipMemsetAsync((char*)d_ws + WS_CTL, 0, CTL_ZERO_BYTES, stream) != hipSuccess) return;
    Args a{};
    for (int i = 0; i < 20; ++i) a.in[i] = (const float*)d_in[i];
    a.out = (float*)d_out; a.ws = (unsigned char*)d_ws;
#if MK_PER_PHASE
    for (int p = 0; p < N_PHASES; ++p) { a.ph_lo = p; a.ph_hi = p + 1; hipLaunchKernelGGL(fwd_kernel, dim3(grid), dim3(NWAVES * 64), LDS_BYTES, stream, a); }
#else
    a.ph_lo = 0; a.ph_hi = N_PHASES;
    hipLaunchKernelGGL(fwd_kernel, dim3(grid), dim3(NWAVES * 64), LDS_BYTES, stream, a);
#endif
}
```

```cpp
#define CJ_TA1 20000
#define CJ_TC0 23776
#include <hip/hip_runtime.h>
#include <cstdio>
#include <cstdint>
#ifndef PG8_WGM
#define PG8_WGM 8
#endif
#ifndef PG8_XROW
#define PG8_XROW 0
#endif
#ifndef PG8_MERGE_LAST
#define PG8_MERGE_LAST 1
#endif
#ifndef MK_PER_PHASE
#define MK_PER_PHASE 0
#endif
namespace pg8 {
#define PG8_LAS __attribute__((address_space(3)))
typedef unsigned short bf16_t;
typedef short bf16x8 __attribute__((ext_vector_type(8)));
typedef float f32x4 __attribute__((ext_vector_type(4)));
typedef unsigned u32x4 __attribute__((ext_vector_type(4)));
constexpr int BM = 256, BK = 64, HALF = 128, HTB = HALF * BK * 2  , STAGE_BYTES = 8 * HTB, NXCD = 8, WGM = PG8_WGM;

__host__ __device__ __forceinline__ int lds_byte(int r, int c) { const int st = (r >> 4) * 2 + (c >> 5), rr = r & 15, cc = c & 31, ob = rr * 64 + cc * 2; return st * 1024 + (ob ^ (((ob >> 9) & 1) << 5)); }
__host__ __device__ __forceinline__ void stage_rc(int b, int& R, int& C) { const int st = b / 1024, sb = b % 1024, swz = sb ^ (((sb >> 9) & 1) << 5); R = (st >> 1) * 16 + swz / 64; C = (st & 1) * 32 + (swz % 64) / 2; }
__host__ __device__ __forceinline__ int perm32(int rho) { const int n = rho >> 4, i = rho & 15; return 8 * (i >> 2) + 4 * n + (i & 3); }

struct Unit { int pm, pn, kt0, nt, slab; };
struct Gemm { const bf16_t* A; const bf16_t* Bt; int M, N, K; };

struct StaticOrder {
    int nM, nN, nwg, G, c, ntk;
    __host__ __device__ void init(int M, int N, int G_, int c_, int K_) { nM = M / BM; nN = N / BM; nwg = nM * nN; G = G_; c = c_; ntk = K_ / BK; }
    __host__ __device__ __forceinline__ bool next(int i, Unit& u) const {
#if PG8_XROW
        u.kt0 = 0; u.nt = ntk; u.slab = -1;
        const int xcd = c & 7, j = c >> 3, mloc = j & 3, nloc = j >> 2, R = (nN + 7) >> 3, f = nN - 8 * (R - 1);
        if (i < R) { const int pn = 8 * i + nloc; if (pn < nN) { u.pm = 4 * xcd + mloc; u.pn = pn; return true; }
            if (nM <= 32) return false;
            const int s = ((nloc - f) * 4 + mloc) * 8 + xcd; if (s < nN) { u.pm = 32; u.pn = s; return true; } return false; }
        if (i == R && nM > 32) { const int s = 32 * (8 - f) + c; if (s < nN) { u.pm = 32; u.pn = s; return true; } }
        return false;
#else
        const long L = (long)i * G + c; if (L >= nwg) return false;
        int wgid = (int)L; { const int q = nwg / NXCD, r = nwg % NXCD, xcd = wgid % NXCD, off = wgid / NXCD; wgid = (xcd < r ? xcd * (q + 1) : r * (q + 1) + (xcd - r) * q) + off; }
#if PG8_MERGE_LAST
        const int nig = WGM * nN, ngrp0 = (nM + WGM - 1) / WGM, rem = nM - (ngrp0 - 1) * WGM, ngrp = (ngrp0 > 1 && rem <= WGM / 2) ? ngrp0 - 1 : ngrp0;
        const int gid0 = wgid / nig, gid = gid0 < ngrp - 1 ? gid0 : ngrp - 1, fm = gid * WGM, gsz = (gid == ngrp - 1) ? nM - fm : WGM, loc = wgid - gid * nig;
        u.pm = fm + (loc % gsz); u.pn = loc / gsz;
#else
        const int nig = WGM * nN, gid = wgid / nig, fm = gid * WGM, gsz = (nM - fm) < WGM ? (nM - fm) : WGM;
        u.pm = fm + ((wgid % nig) % gsz); u.pn = (wgid % nig) / gsz;
#endif
        u.kt0 = 0; u.nt = ntk; u.slab = -1; return true;
#endif
    }
    __device__ __forceinline__ void a_ready(const Unit&) const {}
    __device__ __forceinline__ void done(const Unit&) const {}
};

struct HotOrder : StaticOrder {
    int nrounds;
    __host__ __device__ __forceinline__ bool next(int i, Unit& u) const { if (i >= nrounds) return false; u.pm = (c >> 1) & 3; u.pn = c & 1; u.kt0 = 0; u.nt = ntk; u.slab = -1; return true; }
};

struct SplitOrder : StaticOrder {
    int nfull;
    __host__ __device__ void init2(int Mfull, int N, int G_, int c_, int K_) { init(Mfull, N, G_, c_, K_); nfull = nwg / G_; }
    __host__ __device__ __forceinline__ bool next(int i, Unit& u) const {
#ifndef SPLIT_REPS
#define SPLIT_REPS 1
#endif
        if (i > nfull + SPLIT_REPS - 1) return false;
        const bool split = (i < SPLIT_REPS);
        Unit f; f.pm = 0; f.pn = 0; f.kt0 = 0; f.nt = ntk; f.slab = -1;
        (void)StaticOrder::next(split ? 0 : i - SPLIT_REPS, f);
        const int pn = c & 15, s = c >> 4, npair = ntk >> 1, q = npair >> 4, r = npair & 15;
        const int k0 = 2 * (s < r ? s * (q + 1) : r * (q + 1) + (s - r) * q), ntp = 2 * (s < r ? q + 1 : q);
        u.pm = split ? nM : f.pm; u.pn = split ? pn : f.pn; u.kt0 = split ? k0 : 0; u.nt = split ? ntp : ntk; u.slab = split ? s : -1;
        return true;
    }
};

__device__ __forceinline__ unsigned cvt_pk_bf16(float lo, float hi) { unsigned r; asm volatile("v_cvt_pk_bf16_f32 %0, %1, %2" : "=v"(r) : "v"(lo), "v"(hi)); return r; }
typedef float f32x2 __attribute__((ext_vector_type(2)));
__device__ __forceinline__ float gelu_tanh(float x) {
    const float t = x * (-2.302208198f - 0.1029432397f * x * x);
    const float e = __builtin_amdgcn_exp2f(t);
    return x * __builtin_amdgcn_rcpf(1.0f + e);
}
__device__ __forceinline__ f32x4 gelu4(f32x4 v) { return (f32x4){gelu_tanh(v[0]), gelu_tanh(v[1]), gelu_tanh(v[2]), gelu_tanh(v[3])}; }
__device__ __forceinline__ u32x4 pack8(f32x4 v0, f32x4 v1) { u32x4 w; w.x = cvt_pk_bf16(v0[0], v0[1]); w.y = cvt_pk_bf16(v0[2], v0[3]); w.z = cvt_pk_bf16(v1[0], v1[1]); w.w = cvt_pk_bf16(v1[2], v1[3]); return w; }

struct EpiPlain {
    static constexpr bool PERM = true, AFTER_DRAIN = false, TWICE = false, APERM = false;
    bf16_t* O; int ldc; bf16_t* slabs;
    __device__ __forceinline__ void prefetch(const Unit&, int, int) const {}
    __device__ __forceinline__ void operator()(const f32x4 (&acc)[2][2][4][2], const Unit& u, int wr, int wc, int fr, int fq) const {
        asm volatile("" : "+v"(fr), "+v"(fq));
        const int rt0 = wr * 64 + fr, col0 = u.pn * BM + wc * 32 + 8 * fq;
        if (u.slab < 0) {
            bf16_t* ob = O + (size_t)(u.pm * BM + rt0) * ldc + col0;
#pragma unroll
            for (int ai = 0; ai < 2; ++ai)
#pragma unroll
                for (int m = 0; m < 4; ++m) {
#pragma unroll
                    for (int bj = 0; bj < 2; ++bj) *(u32x4*)(ob + (size_t)(ai * HALF + m * 16) * ldc + bj * HALF) = pack8(acc[ai][bj][m][0], acc[ai][bj][m][1]); }
        } else {
            bf16_t* sb = slabs + ((size_t)u.slab * BM + rt0) * ldc + col0;
#pragma unroll
            for (int ai = 0; ai < 2; ++ai)
#pragma unroll
                for (int m = 0; m < 4; ++m) {
#pragma unroll
                    for (int bj = 0; bj < 2; ++bj) *(u32x4*)(sb + (size_t)(ai * HALF + m * 16) * ldc + bj * HALF) = pack8(acc[ai][bj][m][0], acc[ai][bj][m][1]); }
        }
    }
};

struct EpiIn {
    static constexpr bool PERM = true, AFTER_DRAIN = false, TWICE = false, APERM = false;
    bf16_t* Z; float* ssq;
    float *out_pk, *out_pv, *out_sk, *out_sv;
    const float* rs; PG8_LAS unsigned char* aux;
    __device__ __forceinline__ void prefetch(const Unit& u, int wid, int lane) const {
        const float* r0 = rs + u.pm * BM + (wid >> 2) * 64 + lane;
        __builtin_amdgcn_global_load_lds((const unsigned*)r0, (PG8_LAS unsigned*)(aux + wid * 512), 4, 0, 0);
        __builtin_amdgcn_global_load_lds((const unsigned*)(r0 + HALF), (PG8_LAS unsigned*)(aux + wid * 512 + 256), 4, 0, 0);
    }
    __device__ __forceinline__ void operator()(const f32x4 (&acc)[2][2][4][2], const Unit& u, int wr, int wc, int fr, int fq) const {
        constexpr int LDZ = 6656;
        asm volatile("" : "+v"(fr), "+v"(fq));
        const int pn = u.pn;
        const bool is_q = pn < 8, is_kv = (pn == 8) || (pn == 9), is_gelu = pn >= 10, is_v = pn >= 18;
        const float scale = is_q ? 0.125f : 1.0f;
        const PG8_LAS float* rl = (const PG8_LAS float*)(aux + (wr * 4 + wc) * 512) + fr;
        const int rt0 = wr * 64 + fr, col0 = pn * BM + wc * 32 + 8 * fq, c0 = wc * 32 + 8 * fq;
        bf16_t* zb = Z + (size_t)(u.pm * BM + rt0) * LDZ + col0;
        const int pidx = (pn - 18) * 4 + wc;
        float* fo = nullptr; bool fo_hi_only = false;
        if (is_kv) { if (u.pm == 32) fo = ((pn == 8) ? out_sk : out_sv) + (size_t)rt0 * 256 + c0;
                     else if ((u.pm & 7) == 7) { fo = ((pn == 8) ? out_pk : out_pv) + ((size_t)(u.pm >> 3) * 128 + rt0 - 128) * 256 + c0; fo_hi_only = true; } }
#pragma unroll
        for (int ai = 0; ai < 2; ++ai)
#pragma unroll
            for (int m = 0; m < 4; ++m) { const int ro = ai * HALF + m * 16; float s = 0.f; const float rsc = rl[ai * 64 + m * 16] * scale;
#pragma unroll
                for (int bj = 0; bj < 2; ++bj) { f32x4 v0 = acc[ai][bj][m][0] * rsc, v1 = acc[ai][bj][m][1] * rsc;
                    if (is_gelu) { v0 = gelu4(v0); v1 = gelu4(v1); }
                    if (is_v) s += (v0[0] * v0[0] + v0[1] * v0[1]) + (v0[2] * v0[2] + v0[3] * v0[3]) + (v1[0] * v1[0] + v1[1] * v1[1]) + (v1[2] * v1[2] + v1[3] * v1[3]);
                    *(u32x4*)(zb + (size_t)ro * LDZ + bj * HALF) = pack8(v0, v1);
                    if (fo != nullptr && (!fo_hi_only || ai == 1)) { float* d = fo + (size_t)ro * 256 + bj * HALF; *(f32x4*)d = v0; *(f32x4*)(d + 4) = v1; } }
                if (is_v) { s += __shfl_xor(s, 16); s += __shfl_xor(s, 32); if (fq == 0) ssq[(size_t)(u.pm * BM + rt0 + ro) * 32 + pidx] = s; }
                asm volatile("" ::: "memory"); }
    }
};

__device__ __forceinline__ float dpp_shr1(float old, float src) { return __builtin_bit_cast(float, __builtin_amdgcn_update_dpp(__builtin_bit_cast(int, old), __builtin_bit_cast(int, src), 0x111, 0xf, 0xf, false)); }
__device__ __forceinline__ float dpp_shr2(float old, float src) { return __builtin_bit_cast(float, __builtin_amdgcn_update_dpp(__builtin_bit_cast(int, old), __builtin_bit_cast(int, src), 0x112, 0xf, 0xf, false)); }
__device__ __forceinline__ float dpp_ror1(float src) { return __builtin_bit_cast(float, __builtin_amdgcn_update_dpp(0, __builtin_bit_cast(int, src), 0x121, 0xf, 0xf, false)); }
__device__ __forceinline__ float dpp_ror2(float src) { return __builtin_bit_cast(float, __builtin_amdgcn_update_dpp(0, __builtin_bit_cast(int, src), 0x122, 0xf, 0xf, false)); }

#ifndef EPIGU_NT
#define EPIGU_NT 0
#endif
#ifndef EPIGU_TWICE
#define EPIGU_TWICE false
#endif
struct EpiGU {
    static constexpr bool PERM = true, AFTER_DRAIN = false, TWICE = EPIGU_TWICE, APERM = true;
    bf16_t* A; bf16_t* halo;
    const float *cw, *cb, *state;
    float *out_pc, *out_sc;
    PG8_LAS unsigned char* aux;
    const float* rs;
    __device__ __forceinline__ void prefetch(const Unit& u, int wid, int lane) const {
        const int f = u.pn * 128 + (wid & 3) * 32 + (lane & 31);
        const float* g0 = (lane < 32 ? cw : cw + 11008) + f; const float* g1 = (lane < 32 ? cw + 2 * 11008 : cb) + f;
        __builtin_amdgcn_global_load_lds((const unsigned*)g0, (PG8_LAS unsigned*)(aux + wid * 1024), 4, 0, 0);
        __builtin_amdgcn_global_load_lds((const unsigned*)g1, (PG8_LAS unsigned*)(aux + wid * 1024 + 256), 4, 0, 0);
        const float* r0 = rs + u.pm * BM + (wid >> 2) * 64 + lane;
        __builtin_amdgcn_global_load_lds((const unsigned*)r0, (PG8_LAS unsigned*)(aux + wid * 1024 + 512), 4, 0, 0);
        __builtin_amdgcn_global_load_lds((const unsigned*)(r0 + HALF), (PG8_LAS unsigned*)(aux + wid * 1024 + 768), 4, 0, 0);
    }
    template <bool SMP>
    __device__ __forceinline__ void body(const f32x4 (&acc)[2][2][4][2], const Unit& u, int wr, int wc, int fr, int fq) const {
        constexpr int FFN = 11008;
        const int f0 = u.pn * 128 + wc * 32 + 8 * fq;
        const PG8_LAS float* wl = (const PG8_LAS float*)(aux + (wr * 4 + wc) * 1024) + 8 * fq;
        const PG8_LAS float* rl = (const PG8_LAS float*)(aux + (wr * 4 + wc) * 1024 + 512) + 4 * fr;
        const int r0 = wr * 64 + 4 * fr;
        bf16_t* ab = A + (size_t)(u.pm * BM + r0) * FFN + f0;
        const bool ev = (fr & 1) == 0;
#pragma unroll
        for (int ai = 0; ai < 2; ++ai) {
            const int bs = (ai * HALF + r0) >> 3, j64 = u.pm * 4 + ai * 2 + wr;
            const f32x4 rv = *(const PG8_LAS f32x4*)(rl + ai * 64);
            unsigned lo[4][2];
#pragma unroll
            for (int n = 0; n < 2; ++n) {
                const f32x4 w0 = *(const PG8_LAS f32x4*)(wl + 4 * n), w1 = *(const PG8_LAS f32x4*)(wl + 32 + 4 * n), w2 = *(const PG8_LAS f32x4*)(wl + 64 + 4 * n), bb = *(const PG8_LAS f32x4*)(wl + 96 + 4 * n);
                f32x4 gs[4];
#pragma unroll
                for (int m = 0; m < 4; ++m) gs[m] = acc[ai][0][m][n] * rv[m];
                f32x4 d2, d3;
#pragma unroll
                for (int e = 0; e < 4; ++e) { d2[e] = dpp_shr1(0.f, gs[2][e]); d3[e] = dpp_shr1(0.f, gs[3][e]); }
                if constexpr (SMP) { if (ev) { const float* sp_ = state + (size_t)bs * 2 * FFN + f0 + 4 * n; d2 = *(const f32x4*)sp_; d3 = *(const f32x4*)(sp_ + FFN); } }
#pragma unroll
                for (int m = 0; m < 4; ++m) {
                    const f32x4 us = acc[ai][1][m][n] * rv[m];
                    const f32x4 p1 = (m == 0) ? d3 : gs[m > 0 ? m - 1 : 0];
                    const f32x4 p2 = (m == 0) ? d2 : (m == 1) ? d3 : gs[m > 1 ? m - 2 : 0];
                    const f32x4 c = w0 * p2 + w1 * p1 + w2 * gs[m] + bb;
                    const f32x4 av = gelu4(c) * us;
                    const unsigned q0 = cvt_pk_bf16(av[0], av[1]), q1 = cvt_pk_bf16(av[2], av[3]);
                    if (n == 0) { lo[m][0] = q0; lo[m][1] = q1; }
                    else if (SMP || m >= 2 || fr != 0) { u32x4 pk_; pk_.x = lo[m][0]; pk_.y = lo[m][1]; pk_.z = q0; pk_.w = q1; *(u32x4*)(ab + (size_t)(ai * HALF + m) * FFN) = pk_; }
                    if constexpr (SMP) {
                        if (m >= 2 && !ev) *(f32x4*)(out_sc + ((size_t)bs * 2 + (m - 2)) * FFN + f0 + 4 * n) = gs[m];
                    } else {
                        if (m < 2 && fr == 0) { bf16_t* hg = halo + ((size_t)j64 * 6 + m) * FFN + f0 + 4 * n; *(uint2*)hg = make_uint2(cvt_pk_bf16(gs[m][0], gs[m][1]), cvt_pk_bf16(gs[m][2], gs[m][3])); *(uint2*)(hg + 2 * FFN) = make_uint2(cvt_pk_bf16(us[0], us[1]), cvt_pk_bf16(us[2], us[3])); }
                        if (m >= 2 && fr == 15) { bf16_t* hg = halo + ((size_t)j64 * 6 + 4 + (m - 2)) * FFN + f0 + 4 * n; *(uint2*)hg = make_uint2(cvt_pk_bf16(gs[m][0], gs[m][1]), cvt_pk_bf16(gs[m][2], gs[m][3]));
                            if ((u.pm & 7) == 7 && ai == 1 && wr == 1) *(f32x4*)(out_pc + ((size_t)(u.pm >> 3) * 2 + (m - 2)) * FFN + f0 + 4 * n) = gs[m]; }
                    }
                }
                asm volatile("" ::: "memory");
            }
        }
    }
    __device__ __forceinline__ void operator()(const f32x4 (&acc)[2][2][4][2], const Unit& u, int wr, int wc, int fr, int fq) const {
        asm volatile("" : "+v"(fr), "+v"(fq));
        if (u.pm == 32) body<true>(acc, u, wr, wc, fr, fq); else body<false>(acc, u, wr, wc, fr, fq);
    }
};

template <class Epi, class Sched, bool ALIGN_EPI = false, bool SP2 = false>
__device__ __forceinline__ void gemm_phase(PG8_LAS unsigned char* lds, const Gemm g, const Sched& S, const Epi& E, int wave_in) {
    int wv_l = wave_in; asm volatile("" : "+s"(wv_l)); int ln_l; asm volatile("v_mbcnt_lo_u32_b32 %0, -1, 0\n\tv_mbcnt_hi_u32_b32 %0, -1, %0" : "=v"(ln_l)); const int tid_l = wv_l * 64 + ln_l;
    const int tid = tid_l, wid = __builtin_amdgcn_readfirstlane(tid >> 6), lane = tid & 63, wr = wid >> 2, wc = wid & 3, fr = lane & 15, fq = lane >> 4;
    const int K = g.K;
    unsigned voffA[2], voffB[2];
#pragma unroll
    for (int i = 0; i < 2; ++i) { int R, C; stage_rc(tid * 16 + i * 8192, R, C); const int Rb = Epi::PERM ? ((R & ~31) + perm32(R & 31)) : R;
        const int Ra = Epi::APERM ? ((R & 64) + 4 * (R & 15) + ((R >> 4) & 3)) : R;
        voffA[i] = (unsigned)(Ra * K + C) * 2u; voffB[i] = (unsigned)(Rb * K + C) * 2u; }
    const size_t kstep = (size_t)(BK * 2);
    const size_t hstep = (size_t)HALF * K * 2;
    const size_t tstep = 2 * hstep;
    const unsigned ldsw = (unsigned)wid * 1024u;
    const int aoff = lds_byte(wr * 64 + fr, fq * 8), boff = lds_byte(wc * 32 + fr, fq * 8);
#define PG8_SA(b, h) (((b) * 2 + (h)) * HTB)
#define PG8_SB(b, h) ((4 + (b) * 2 + (h)) * HTB)
#define PG8_STAGE(bufoff, gbase, voff) do { _Pragma("unroll") for (int _i = 0; _i < 2; ++_i) \
        __builtin_amdgcn_global_load_lds((const unsigned*)((const char*)(gbase) + (voff)[_i]), (PG8_LAS unsigned*)(lds + (bufoff) + ldsw + _i * 8192), 16, 0, 0); } while (0)
#ifndef PG8_B_AUX
#define PG8_B_AUX 0
#endif
#define PG8_STAGEB(bufoff, gbase, voff) do { _Pragma("unroll") for (int _i = 0; _i < 2; ++_i) \
        __builtin_amdgcn_global_load_lds((const unsigned*)((const char*)(gbase) + (voff)[_i]), (PG8_LAS unsigned*)(lds + (bufoff) + ldsw + _i * 8192), 16, 0, PG8_B_AUX); } while (0)
#define PG8_LDA(dst, b, h) do { _Pragma("unroll") for (int m = 0; m < 4; ++m) _Pragma("unroll") for (int k = 0; k < 2; ++k) dst[m][k] = *(const PG8_LAS bf16x8*)(lds + PG8_SA(b, h) + aoff + m * 2048 + k * 1024); } while (0)
#define PG8_LDB(dst, b, h) do { _Pragma("unroll") for (int n = 0; n < 2; ++n) _Pragma("unroll") for (int k = 0; k < 2; ++k) dst[n][k] = *(const PG8_LAS bf16x8*)(lds + PG8_SB(b, h) + boff + n * 2048 + k * 1024); } while (0)
#ifndef PG8_PRIO
#define PG8_PRIO 1
#endif
#define PG8_MMA(ai, bj, At, Bt) do { if (PG8_PRIO) __builtin_amdgcn_s_setprio(PG8_PRIO); _Pragma("unroll") for (int m = 0; m < 4; ++m) _Pragma("unroll") for (int n = 0; n < 2; ++n) _Pragma("unroll") for (int k = 0; k < 2; ++k) \
        acc[ai][bj][m][n] = __builtin_amdgcn_mfma_f32_16x16x32_bf16(Bt[n][k], At[m][k], acc[ai][bj][m][n], 0, 0, 0); if (PG8_PRIO) __builtin_amdgcn_s_setprio(0); } while (0)
#ifndef PG8_PRIO_MODE
#define PG8_PRIO_MODE 1
#endif
#define PG8_MMA_NP(ai, bj, At, Bt) do { _Pragma("unroll") for (int m = 0; m < 4; ++m) _Pragma("unroll") for (int n = 0; n < 2; ++n) _Pragma("unroll") for (int k = 0; k < 2; ++k) \
        acc[ai][bj][m][n] = __builtin_amdgcn_mfma_f32_16x16x32_bf16(Bt[n][k], At[m][k], acc[ai][bj][m][n], 0, 0, 0); } while (0)
#ifndef PG8_EARLYBAR
#define PG8_EARLYBAR 0
#endif
#define PG8_MMA_M(ai, bj, At, Bt, M0, M1) do { _Pragma("unroll") for (int m = (M0); m < (M1); ++m) _Pragma("unroll") for (int n = 0; n < 2; ++n) _Pragma("unroll") for (int k = 0; k < 2; ++k) \
        acc[ai][bj][m][n] = __builtin_amdgcn_mfma_f32_16x16x32_bf16(Bt[n][k], At[m][k], acc[ai][bj][m][n], 0, 0, 0); } while (0)
#if PG8_PRIO_MODE == 0
#define PG8_MMAX(ai, bj, At, Bt) PG8_MMA(ai, bj, At, Bt)
#define PG8_PRI_PRE
#define PG8_PRI_ON
#define PG8_PRI_OFF
#define PG8_PRI_POST
#elif PG8_PRIO_MODE == 1
#define PG8_MMAX(ai, bj, At, Bt) PG8_MMA_NP(ai, bj, At, Bt)
#define PG8_PRI_PRE
#define PG8_PRI_ON __builtin_amdgcn_s_setprio(1)
#define PG8_PRI_OFF __builtin_amdgcn_s_setprio(0)
#define PG8_PRI_POST
#else
#define PG8_MMAX(ai, bj, At, Bt) PG8_MMA_NP(ai, bj, At, Bt)
#define PG8_PRI_PRE __builtin_amdgcn_s_setprio(1)
#define PG8_PRI_ON
#define PG8_PRI_OFF
#define PG8_PRI_POST __builtin_amdgcn_s_setprio(0)
#endif
#define PG8_WAIT_V(n) asm volatile("s_waitcnt vmcnt(" #n ")" ::: "memory")
#define PG8_WAIT_L(n) asm volatile("s_waitcnt lgkmcnt(" #n ")" ::: "memory")
#define PG8_BAR __builtin_amdgcn_s_barrier()
#define PG8_SCHED __builtin_amdgcn_sched_barrier(0)
    Unit cur, nxt; int ui = 0;
    if (!S.next(0, cur)) return;
    f32x4 acc[2][2][4][2];
#pragma unroll
    for (int a = 0; a < 2; ++a)
#pragma unroll
        for (int b = 0; b < 2; ++b)
#pragma unroll
            for (int m = 0; m < 4; ++m)
#pragma unroll
                for (int n = 0; n < 2; ++n) acc[a][b][m][n] = (f32x4){0.f, 0.f, 0.f, 0.f};
    bf16x8 At[4][2], B0[2][2], B1[2][2];
    const char* cA = (const char*)g.A + (size_t)cur.pm * tstep + (size_t)cur.kt0 * kstep; const char* cB = (const char*)g.Bt + (size_t)cur.pn * tstep + (size_t)cur.kt0 * kstep;
    S.a_ready(cur);
    if constexpr (SP2) {
        PG8_STAGEB(PG8_SB(0, 0), cB, voffB); PG8_STAGEB(PG8_SB(0, 1), cB + hstep, voffB); PG8_STAGE(PG8_SA(0, 0), cA, voffA); PG8_STAGE(PG8_SA(0, 1), cA + hstep, voffA);
        if (wr == 1) PG8_BAR;
        PG8_WAIT_V(2); PG8_BAR;
        PG8_STAGEB(PG8_SB(1, 0), cB + kstep, voffB); PG8_STAGE(PG8_SA(1, 0), cA + kstep, voffA); PG8_STAGEB(PG8_SB(1, 1), cB + hstep + kstep, voffB);
        PG8_WAIT_V(6); PG8_BAR;
    } else {
        PG8_STAGEB(PG8_SB(0, 0), cB, voffB); PG8_STAGE(PG8_SA(0, 0), cA, voffA); PG8_STAGEB(PG8_SB(0, 1), cB + hstep, voffB); PG8_STAGE(PG8_SA(0, 1), cA + hstep, voffA);
        if (wr == 1) PG8_BAR;
        PG8_WAIT_V(4); PG8_BAR;
        PG8_STAGEB(PG8_SB(1, 0), cB + kstep, voffB); PG8_STAGE(PG8_SA(1, 0), cA + kstep, voffA); PG8_STAGEB(PG8_SB(1, 1), cB + hstep + kstep, voffB);
        PG8_WAIT_V(6); PG8_BAR;
    }
    for (;;) {
        const bool has_next = S.next(ui + 1, nxt);
        const char* nA = has_next ? (const char*)g.A + (size_t)nxt.pm * tstep + (size_t)nxt.kt0 * kstep : cA; const char* nB = has_next ? (const char*)g.Bt + (size_t)nxt.pn * tstep + (size_t)nxt.kt0 * kstep : cB;
        const int nt = cur.nt;
        E.prefetch(cur, wid, lane);
        for (int t = 0; t < nt; t += 2) {
            const bool last = (t == nt - 2);
            const char* a1 = cA + (size_t)(t + 1) * kstep;
            const char* a2 = last ? nA : cA + (size_t)(t + 2) * kstep; const char* b2 = last ? nB : cB + (size_t)(t + 2) * kstep;
            const char* a3 = a2 + kstep; const char* b3 = b2 + kstep;
            if (last && has_next) S.a_ready(nxt);
            if constexpr (SP2) {
            PG8_LDB(B0, 0, 0); PG8_LDB(B1, 0, 1); PG8_SCHED; PG8_LDA(At, 0, 0); PG8_STAGE(PG8_SA(1, 1), a1 + hstep, voffA);
            PG8_WAIT_V(8); PG8_WAIT_L(0); PG8_BAR; if constexpr (PG8_EARLYBAR != 0) { __builtin_amdgcn_s_setprio(1); PG8_MMA_M(0, 0, At, B0, 0, 4); PG8_MMA_M(0, 1, At, B1, 0, 4 - PG8_EARLYBAR); __builtin_amdgcn_s_setprio(0); PG8_SCHED; PG8_BAR; PG8_SCHED; __builtin_amdgcn_s_setprio(1); PG8_MMA_M(0, 1, At, B1, 4 - PG8_EARLYBAR, 4); __builtin_amdgcn_s_setprio(0); } else { PG8_PRI_ON; PG8_MMAX(0, 0, At, B0); PG8_MMAX(0, 1, At, B1); PG8_PRI_OFF; PG8_BAR; } PG8_SCHED;
            PG8_LDA(At, 0, 1); PG8_STAGEB(PG8_SB(0, 0), b2, voffB); PG8_STAGEB(PG8_SB(0, 1), b2 + hstep, voffB); PG8_STAGE(PG8_SA(0, 0), a2, voffA);
            PG8_WAIT_V(8); PG8_WAIT_L(0); PG8_BAR; if constexpr (PG8_EARLYBAR != 0) { __builtin_amdgcn_s_setprio(1); PG8_MMA_M(1, 0, At, B0, 0, 4); PG8_MMA_M(1, 1, At, B1, 0, 4 - PG8_EARLYBAR); __builtin_amdgcn_s_setprio(0); PG8_SCHED; PG8_BAR; PG8_SCHED; __builtin_amdgcn_s_setprio(1); PG8_MMA_M(1, 1, At, B1, 4 - PG8_EARLYBAR, 4); __builtin_amdgcn_s_setprio(0); } else { PG8_PRI_ON; PG8_MMAX(1, 0, At, B0); PG8_MMAX(1, 1, At, B1); PG8_PRI_OFF; PG8_BAR; } PG8_SCHED;
            PG8_LDB(B0, 1, 0); PG8_LDB(B1, 1, 1); PG8_SCHED; PG8_LDA(At, 1, 0); PG8_STAGE(PG8_SA(0, 1), a2 + hstep, voffA);
            PG8_WAIT_V(8); PG8_WAIT_L(0); PG8_BAR; if constexpr (PG8_EARLYBAR != 0) { __builtin_amdgcn_s_setprio(1); PG8_MMA_M(0, 0, At, B0, 0, 4); PG8_MMA_M(0, 1, At, B1, 0, 4 - PG8_EARLYBAR); __builtin_amdgcn_s_setprio(0); PG8_SCHED; PG8_BAR; PG8_SCHED; __builtin_amdgcn_s_setprio(1); PG8_MMA_M(0, 1, At, B1, 4 - PG8_EARLYBAR, 4); __builtin_amdgcn_s_setprio(0); } else { PG8_PRI_ON; PG8_MMAX(0, 0, At, B0); PG8_MMAX(0, 1, At, B1); PG8_PRI_OFF; PG8_BAR; } PG8_SCHED;
            PG8_LDA(At, 1, 1); PG8_STAGEB(PG8_SB(1, 0), b3, voffB); PG8_STAGEB(PG8_SB(1, 1), b3 + hstep, voffB); PG8_STAGE(PG8_SA(1, 0), a3, voffA);
            PG8_WAIT_V(8); PG8_WAIT_L(0); PG8_BAR; if constexpr (PG8_EARLYBAR != 0) { __builtin_amdgcn_s_setprio(1); PG8_MMA_M(1, 0, At, B0, 0, 4); PG8_MMA_M(1, 1, At, B1, 0, 4 - PG8_EARLYBAR); __builtin_amdgcn_s_setprio(0); PG8_SCHED; PG8_BAR; PG8_SCHED; __builtin_amdgcn_s_setprio(1); PG8_MMA_M(1, 1, At, B1, 4 - PG8_EARLYBAR, 4); __builtin_amdgcn_s_setprio(0); } else { PG8_PRI_ON; PG8_MMAX(1, 0, At, B0); PG8_MMAX(1, 1, At, B1); PG8_PRI_OFF; PG8_BAR; } PG8_SCHED;
            } else {
            PG8_LDB(B0, 0, 0); PG8_SCHED; PG8_LDA(At, 0, 0); PG8_STAGE(PG8_SA(1, 1), a1 + hstep, voffA);
            PG8_WAIT_L(8); PG8_BAR; PG8_WAIT_L(0); PG8_MMA(0, 0, At, B0); PG8_BAR; PG8_SCHED;
            PG8_LDB(B1, 0, 1); PG8_STAGEB(PG8_SB(0, 0), b2, voffB);
            PG8_BAR; PG8_WAIT_L(0); PG8_MMA(0, 1, At, B1); PG8_BAR;
            PG8_LDA(At, 0, 1); PG8_STAGE(PG8_SA(0, 0), a2, voffA);
            PG8_BAR; PG8_WAIT_L(0); PG8_MMA(1, 0, At, B0); PG8_BAR; PG8_SCHED;
            PG8_STAGEB(PG8_SB(0, 1), b2 + hstep, voffB);
            PG8_WAIT_V(6); PG8_BAR; PG8_MMA(1, 1, At, B1); PG8_BAR;
            PG8_LDB(B0, 1, 0); PG8_SCHED; PG8_LDA(At, 1, 0); PG8_STAGE(PG8_SA(0, 1), a2 + hstep, voffA);
            PG8_WAIT_L(8); PG8_BAR; PG8_WAIT_L(0); PG8_MMA(0, 0, At, B0); PG8_BAR; PG8_SCHED;
            PG8_LDB(B1, 1, 1); PG8_STAGEB(PG8_SB(1, 0), b3, voffB);
            PG8_BAR; PG8_WAIT_L(0); PG8_MMA(0, 1, At, B1); PG8_BAR;
            PG8_LDA(At, 1, 1); PG8_STAGE(PG8_SA(1, 0), a3, voffA);
            PG8_BAR; PG8_WAIT_L(0); PG8_MMA(1, 0, At, B0); PG8_BAR; PG8_SCHED;
            PG8_STAGEB(PG8_SB(1, 1), b3 + hstep, voffB);
            PG8_WAIT_V(6); PG8_BAR; PG8_MMA(1, 1, At, B1); PG8_BAR;
            }
        }
        if constexpr (ALIGN_EPI) { if (wr == 0) PG8_BAR; }
        if constexpr (!Epi::AFTER_DRAIN) { E(acc, cur, wr, wc, fr, fq); if constexpr (Epi::TWICE) { asm volatile("" ::: "memory"); E(acc, cur, wr, wc, fr, fq); } S.done(cur); }
        if (!has_next) break;
#pragma unroll
        for (int a = 0; a < 2; ++a)
#pragma unroll
            for (int b = 0; b < 2; ++b)
#pragma unroll
                for (int m = 0; m < 4; ++m)
#pragma unroll
                    for (int n = 0; n < 2; ++n) acc[a][b][m][n] = (f32x4){0.f, 0.f, 0.f, 0.f};
        cur = nxt; cA = nA; cB = nB; ++ui;
        if constexpr (ALIGN_EPI) { if (wr == 1) PG8_BAR; }
    }
    PG8_WAIT_V(0);
    if constexpr (!ALIGN_EPI) { if (wr == 0) PG8_BAR; }
    PG8_BAR;
    if constexpr (Epi::AFTER_DRAIN) { E.fused(acc, cur, wr, wc, fr, fq, lds, wid, lane); S.done(cur); }
#undef PG8_SA
#undef PG8_SB
#undef PG8_STAGE
#undef PG8_STAGEB
#undef PG8_LDA
#undef PG8_LDB
#undef PG8_MMA
#undef PG8_MMA_NP
#undef PG8_MMA_M
#undef PG8_MMAX
#undef PG8_PRI_PRE
#undef PG8_PRI_ON
#undef PG8_PRI_OFF
#undef PG8_PRI_POST
#undef PG8_WAIT_V
#undef PG8_WAIT_L
#undef PG8_BAR
#undef PG8_SCHED
}
}
#ifndef SKIP_MASK
#define SKIP_MASK 0
#endif
#define SK(b) (((SKIP_MASK) >> (b)) & 1)
#ifndef REPEAT_MASK
#define REPEAT_MASK 0
#endif
#define RP(b) (((REPEAT_MASK) >> (b)) & 1)
#ifndef PG8_SP2
#define PG8_SP2 true
#endif
#ifndef PG8_ALIGN
#define PG8_ALIGN true
#endif
constexpr int NWAVES = 8;
constexpr int DM = 4096, NPR = 8192, NSM = 256, MT = NPR + NSM, SEQL = 2048, NBATCH = 4, DBATCH = 32, DSEQ = 8;
constexpr int QCOLS = 2048, KVCOLS = 256, GMW = 2048, INC = 6656, FFN = 11008, NGU = 2 * FFN;
constexpr int COL_K = 2048, COL_V = 2304, COL_U = 2560, COL_GV = 4608;
constexpr int NLAYER = 2;
constexpr float EPS = 1e-6f;
constexpr float LOG2E = 1.4426950408889634f;
constexpr size_t O_YP = 0, O_YS = 33554432, O_PK = 34603008, O_PV = 34865152, O_PC = 35127296, O_SK = 35303424, O_SV = 35434496, O_SC = 35565568, O_SG = 36974592, O_END = 38023168;
constexpr size_t MiB = 1u << 20;
constexpr size_t WS_CTL = 0, CTL_ZERO_BYTES = 64 * 1024;
constexpr size_t WL_IN = 0, WL_OUT = 52 * MiB, WL_GU = 84 * MiB, WL_DN = 256 * MiB, WL_STRIDE = 342 * MiB;
constexpr size_t WS_W = 1 * MiB;
constexpr size_t WS_TRIL = WS_W + 2 * WL_STRIDE;
constexpr size_t WS_H = WS_TRIL + 1 * MiB;
constexpr size_t WS_R1 = WS_H + 66 * MiB;
constexpr size_t WS_Z = WS_R1, WS_MIX = WS_R1 + 108 * MiB, WS_A = WS_R1;
constexpr size_t WS_MF = WS_R1 + 178 * MiB;
constexpr size_t WS_SSQ = WS_MF + 66 * MiB;
constexpr size_t WS_HALO = WS_SSQ + 2 * MiB;
constexpr size_t WS_SLAB = WS_HALO + 33 * MiB;
constexpr size_t WS_XB = WS_SLAB + 64 * MiB;
constexpr size_t WS_RS = WS_XB + 66 * MiB;
constexpr size_t WS_END = WS_RS + 1 * MiB;
static_assert((size_t)INC * DM * 2 <= 52 * MiB && (size_t)DM * DM * 2 <= 32 * MiB && (size_t)NGU * DM * 2 <= 172 * MiB && (size_t)DM * FFN * 2 <= 86 * MiB, "weight map");
static_assert((size_t)MT * INC * 2 <= 108 * MiB && (size_t)MT * DM * 2 <= 66 * MiB && (size_t)MT * FFN * 2 <= 178 * MiB && (size_t)128 * 6 * FFN * 4 <= 33 * MiB, "activation map");
constexpr int CW_BAR = 4096;
constexpr int RING_OFF = 0, RING_BYTES = 131072;
constexpr int LDSCTL_OFF = RING_BYTES, MISC_OFF = LDSCTL_OFF + 320;
constexpr int LDS_BYTES = 147456;
#define GAS __attribute__((address_space(1)))
#define LAS __attribute__((address_space(3)))
typedef unsigned short bf16;
typedef unsigned v4u __attribute__((ext_vector_type(4)));
typedef float f32x4 __attribute__((ext_vector_type(4)));
typedef short bf16x8 __attribute__((ext_vector_type(8)));
typedef GAS unsigned gu32;
typedef GAS unsigned long long gu64;
#define RLX_AGENT __ATOMIC_RELAXED, __HIP_MEMORY_SCOPE_AGENT
#define LDS_WAIT() asm volatile("s_waitcnt lgkmcnt(0)" ::: "memory")
#define VM_WAIT() asm volatile("s_waitcnt vmcnt(0)" ::: "memory")
__device__ __forceinline__ unsigned long long rt() { return __builtin_amdgcn_s_memrealtime(); }
__device__ __forceinline__ unsigned f2bf(float f) { unsigned u = __builtin_bit_cast(unsigned, f); return (u + 0x7fffu + ((u >> 16) & 1u)) >> 16; }
__device__ __forceinline__ unsigned pk2(float lo, float hi) { return f2bf(lo) | (f2bf(hi) << 16); }

#define XB_TMO      128
#define XB_XCNT(j)  (256  + 64 * (j))
#define XB_XSUB(j)  (1280 + 64 * (j))
#define XB_XGEN(j)  (2304 + 64 * (j))
#define XB_TOP      3328
#define XB_TOPGEN   3392
#define XCD_BAR_WORDS 3456
#define XB_SPIN_CAP (1u << 18)

__device__ __forceinline__ unsigned xb_ld(unsigned* p)              { return __hip_atomic_load(p, __ATOMIC_RELAXED, __HIP_MEMORY_SCOPE_AGENT); }
__device__ __forceinline__ unsigned xb_add(unsigned* p, unsigned v) { return __hip_atomic_fetch_add(p, v, __ATOMIC_RELAXED, __HIP_MEMORY_SCOPE_AGENT); }
__device__ __forceinline__ unsigned xb_xcc_id() { return (unsigned)__builtin_amdgcn_s_getreg((3 << 11) | 20) & 0xFu; }
#define XB_SPIN(cond, bar) do { unsigned _sp = 0; while (cond) { __builtin_amdgcn_s_sleep(1); \
    if ((++_sp & 255u) == 0u) { if (xb_ld(&(bar)[XB_TMO])) break; if (_sp > XB_SPIN_CAP) { atomicAdd(&(bar)[XB_TMO], 1u); break; } } } } while (0)

struct XcdBarrier {
    unsigned* bar; unsigned x;
    volatile LAS unsigned* st;
};

__device__ __forceinline__ XcdBarrier xcd_barrier_post(unsigned* bar, volatile LAS unsigned* st) {
    XcdBarrier b; b.bar = bar; b.x = xb_xcc_id(); b.st = st;
    if (threadIdx.x == 0) (void)xb_add(&bar[XB_XCNT(b.x)], 1u);
    return b;
}
__device__ __forceinline__ void xcd_barrier_complete(unsigned* bar, unsigned x, unsigned& nloc, unsigned& nx) {
    const unsigned G = gridDim.x * gridDim.y * gridDim.z;
    unsigned sum, cnt, mine, sp = 0u;
    for (;;) {
        sum = 0u; cnt = 0u; mine = 0u;
#pragma unroll
        for (unsigned j = 0; j < 16; ++j) { const unsigned c = xb_ld(&bar[XB_XCNT(j)]); sum += c; cnt += (c > 0u) ? 1u : 0u; mine = (j == x) ? c : mine; }
        if (sum == G) break;
        __builtin_amdgcn_s_sleep(1);
        if ((++sp & 255u) == 0u) { if (xb_ld(&bar[XB_TMO])) break; if (sp > XB_SPIN_CAP) { atomicAdd(&bar[XB_TMO], 1u); break; } }
    }
    nloc = mine > 0u ? mine : 1u; nx = cnt > 0u ? cnt : 1u;
}

__device__ __forceinline__ void xcd_barrier(const XcdBarrier& b) {
    asm volatile("s_waitcnt vmcnt(0)" ::: "memory");
    __syncthreads();
    if (threadIdx.x == 0) {
        unsigned* bar = b.bar;
        __builtin_amdgcn_s_waitcnt(0);
        unsigned bx_ = b.x; asm volatile("" : "+s"(bx_));
        unsigned nloc = b.st[0], nx = b.st[1];
        if (nloc == 0u) { xcd_barrier_complete(bar, bx_, nloc, nx); b.st[0] = nloc; b.st[1] = nx; }
        const unsigned old = xb_add(&bar[XB_XSUB(bx_)], 1u);
        const unsigned gen = old / nloc;
        if (old + 1u == (gen + 1u) * nloc) {
            __builtin_amdgcn_fence(__ATOMIC_RELEASE, "agent");
            asm volatile("s_waitcnt vmcnt(0)" ::: "memory");
            const unsigned og = xb_add(&bar[XB_TOP], 1u);
            const unsigned tg = og / nx;
            if (og + 1u == (tg + 1u) * nx) xb_add(&bar[XB_TOPGEN], 1u);
            else XB_SPIN(xb_ld(&bar[XB_TOPGEN]) == tg, bar);
            __builtin_amdgcn_fence(__ATOMIC_ACQUIRE, "agent");
            xb_add(&bar[XB_XGEN(bx_)], 1u);
            asm volatile("s_waitcnt vmcnt(0)" ::: "memory");
        } else {
            XB_SPIN(xb_ld(&bar[XB_XGEN(bx_)]) == gen, bar);
            __builtin_amdgcn_fence(__ATOMIC_ACQUIRE, "agent");
            asm volatile("s_waitcnt vmcnt(0)" ::: "memory");
        }
    }
    __syncthreads();
}
typedef float f32x16 __attribute__((ext_vector_type(16)));
typedef unsigned v2u __attribute__((ext_vector_type(2)));
__device__ __forceinline__ unsigned cvtpk(float lo, float hi) { return pg8::cvt_pk_bf16(lo, hi); }
__device__ __forceinline__ float bflo(unsigned w) { return __uint_as_float(w << 16); }
__device__ __forceinline__ float bfhi(unsigned w) { return __uint_as_float(w & 0xffff0000u); }
__device__ __forceinline__ float wave_sum(float v) {
#pragma unroll
    for (int o = 1; o < 64; o <<= 1) v += __shfl_xor(v, o);
    return v;
}
__device__ __forceinline__ int crow(int r, int hi) { return (r & 3) + 8 * (r >> 2) + 4 * hi; }

constexpr int I_IN = (DM / 64) * (INC / 64), I_OUT = (DM / 64) * (DM / 64), I_G = (DM / 64) * (FFN / 64), I_DN = (FFN / 64) * (DM / 64);
constexpr int I_LAYER = I_IN + I_OUT + 2 * I_G + I_DN, I_ALL = NLAYER * I_LAYER;
#ifndef CVT_NT
#define CVT_NT 1
#endif
#if CVT_NT
#define CVT_LD(p) __builtin_nontemporal_load(p)
#else
#define CVT_LD(p) (*(p))
#endif
#ifndef CVT_NTS
#define CVT_NTS 0
#endif
#if CVT_NTS
#define CVT_ST(p, v) __builtin_nontemporal_store((v), (p))
#else
#define CVT_ST(p, v) (*(p) = (v))
#endif
#if 0
#define CVT_LD(p) (*(p))
#endif
struct CvtItem { const float* src; bf16* dst; const float* gain; int N, K, rbase; };
__device__ __forceinline__ CvtItem cvt_decode(const float* const* in, unsigned char* ws, int it) {
    const int l = it >= I_LAYER ? 1 : 0; int r = it - l * I_LAYER;
    unsigned char* wl = ws + WS_W + (size_t)l * WL_STRIDE;
    const float* W; bf16* WT; const float* gn = nullptr; int K, N, mode;
    if (r < I_IN) { W = in[5] + (size_t)l * DM * INC; WT = (bf16*)(wl + WL_IN); K = DM; N = INC; mode = 0; gn = in[11] + l * DM; }
    else if ((r -= I_IN) < I_OUT) { W = in[6] + (size_t)l * DM * DM; WT = (bf16*)(wl + WL_OUT); K = DM; N = DM; mode = 0; }
    else if ((r -= I_OUT) < I_G) { W = in[15] + (size_t)l * DM * FFN; WT = (bf16*)(wl + WL_GU); K = DM; N = FFN; mode = 1; gn = in[13] + l * DM; }
    else if ((r -= I_G) < I_G) { W = in[16] + (size_t)l * DM * FFN; WT = (bf16*)(wl + WL_GU); K = DM; N = FFN; mode = 2; gn = in[13] + l * DM; }
    else { r -= I_G; W = in[17] + (size_t)l * FFN * DM; WT = (bf16*)(wl + WL_DN); K = FFN; N = DM; mode = 0; }
    const int nblk = N >> 6, kb = r / nblk, nb = r - kb * nblk, k0 = kb << 6, n0 = nb << 6;
    CvtItem c; c.N = N; c.K = K; c.src = W + (size_t)k0 * N + n0; c.dst = WT + k0; c.gain = gn ? gn + k0 : nullptr;
    c.rbase = (mode == 0) ? n0 : (2 * (n0 & ~127) + (n0 & 127) + (mode == 2 ? 128 : 0));
    return c;
}
__device__ __forceinline__ void cvt_load(f32x4 (&v)[16], float& gq, const CvtItem& c, int lane) {
    const int kq = lane >> 4, nq = lane & 15;
    gq = c.gain ? c.gain[lane] : 1.0f;
#pragma unroll
    for (int it = 0; it < 16; ++it) v[it] = CVT_LD((const GAS f32x4*)(c.src + (size_t)(4 * it + kq) * c.N + 4 * nq));
}
#ifndef WMASK_BITS
#define WMASK_BITS 2
#endif
#ifndef WMASK_FFN_ONLY
#define WMASK_FFN_ONLY 1
#endif
constexpr int CVT_SCR = 9216 + 256;
__device__ __forceinline__ void cvt_finish(const f32x4 (&v)[16], const float gq, const CvtItem& c, LAS unsigned char* scr, int lane) {
    const int kq = lane >> 4, nq = lane & 15;
    LAS float* gs = (LAS float*)(scr + 9216);
    gs[lane] = gq; LDS_WAIT(); asm volatile("" ::: "memory");
#pragma unroll
    for (int it = 0; it < 16; ++it) { const int k = 4 * it + kq; const float gk = gs[k];
        const unsigned p01 = cvtpk(v[it][0] * gk, v[it][1] * gk), p23 = cvtpk(v[it][2] * gk, v[it][3] * gk);
        LAS unsigned short* d = (LAS unsigned short*)(scr + (4 * nq) * 144 + k * 2);
        d[0] = (unsigned short)(p01 & 0xffffu); d[72] = (unsigned short)(p01 >> 16); d[144] = (unsigned short)(p23 & 0xffffu); d[216] = (unsigned short)(p23 >> 16); }
    LDS_WAIT(); asm volatile("" ::: "memory");
#pragma unroll
    for (int jj = 0; jj < 8; ++jj) { const int n = 8 * jj + (lane >> 3), kc = lane & 7;
        v4u o = *(const LAS v4u*)(scr + n * 144 + kc * 16);
#if WMASK_BITS
        { const bool ffn_ = WMASK_FFN_ONLY ? (c.N == FFN || c.K == FFN) : true;
          const unsigned hb_ = ffn_ ? (1u << (WMASK_BITS - 1)) * 0x00010001u : 0u, mk_ = ffn_ ? ~(((1u << WMASK_BITS) - 1u) * 0x00010001u) : 0xffffffffu;
          o.x = (o.x + hb_) & mk_; o.y = (o.y + hb_) & mk_; o.z = (o.z + hb_) & mk_; o.w = (o.w + hb_) & mk_; }
#endif
        CVT_ST((GAS v4u*)(c.dst + (size_t)(c.rbase + n) * c.K + 8 * kc), o); }
    LDS_WAIT(); asm volatile("" ::: "memory");
}
#ifndef CVT_DEPTH
#define CVT_DEPTH 3
#endif
__device__ __forceinline__ void cvt_range(const float* const* in, unsigned char* ws, int lo, int hi, int iw, int stride, LAS unsigned char* scr, int lane, const bool rev = false) {
    int it = lo + iw; if (it >= hi) return;
    const int flip = lo + hi - 1;
#define CVT_ID(x) (rev ? flip - (x) : (x))
#if CVT_DEPTH == 3
    f32x4 va[16], vb[16], vc[16]; float ga = 1.f, gb = 1.f, gc = 1.f;
    CvtItem ca = cvt_decode(in, ws, CVT_ID(it)), cb = ca, cc = ca;
    cvt_load(va, ga, ca, lane);
    int i1 = it + stride; bool h1 = i1 < hi;
    if (h1) { cb = cvt_decode(in, ws, CVT_ID(i1)); cvt_load(vb, gb, cb, lane); }
#pragma unroll 1
    for (;;) {
        int i2 = i1 + stride; bool h2 = h1 && i2 < hi;
        if (h2) { cc = cvt_decode(in, ws, CVT_ID(i2)); cvt_load(vc, gc, cc, lane); }
        cvt_finish(va, ga, ca, scr, lane);
        if (!h1) break;
        int i3 = i2 + stride; bool h3 = h2 && i3 < hi;
        if (h3) { ca = cvt_decode(in, ws, CVT_ID(i3)); cvt_load(va, ga, ca, lane); }
        cvt_finish(vb, gb, cb, scr, lane);
        if (!h2) break;
        int i4 = i3 + stride; bool h4 = h3 && i4 < hi;
        if (h4) { cb = cvt_decode(in, ws, CVT_ID(i4)); cvt_load(vb, gb, cb, lane); }
        cvt_finish(vc, gc, cc, scr, lane);
        if (!h3) break;
        i1 = i4; h1 = h4;
    }
#else
    f32x4 va[16], vb[16]; float ga = 1.f, gb = 1.f;
    CvtItem ca = cvt_decode(in, ws, CVT_ID(it)), cb = ca;
    cvt_load(va, ga, ca, lane);
#pragma unroll 1
    for (;;) {
        int nx = it + stride; bool hn = nx < hi;
        if (hn) { cb = cvt_decode(in, ws, CVT_ID(nx)); cvt_load(vb, gb, cb, lane); }
        cvt_finish(va, ga, ca, scr, lane);
        if (!hn) break;
        it = nx; nx = it + stride; hn = nx < hi;
        if (hn) { ca = cvt_decode(in, ws, CVT_ID(nx)); cvt_load(va, ga, ca, lane); }
        cvt_finish(vb, gb, cb, scr, lane);
        if (!hn) break;
        it = nx;
    }
#endif
#undef CVT_ID
}
#ifndef CJ_TA0
#define CJ_TA0 23000
#endif
#ifndef CJ_TC0
#define CJ_TC0 29768
#endif
#ifndef CJ_TA1
#define CJ_TA1 14008
#endif
#ifndef CJ_TC1
#define CJ_TC1 11008
#endif
constexpr int CJ_E1 = I_LAYER + I_IN + I_OUT + 2 * I_G;
constexpr int CJ_C0 = CJ_E1 - CJ_TA1, CJ_A0 = CJ_C0 - CJ_TC0, CJ_P1 = CJ_A0 - CJ_TA0, CJ_P2 = I_ALL - CJ_TC1;
static_assert(CJ_P1 >= I_IN && CJ_A0 >= I_IN + I_OUT + 2 * I_G && CJ_C0 >= I_LAYER + I_IN + I_OUT && CJ_P2 >= CJ_E1 && CJ_TA0 >= 0 && CJ_TC0 >= 0 && CJ_TA1 >= 0 && CJ_TC1 >= 0, "conversion schedule");
constexpr int REM_A = ((MT / 256) * (INC / 256)) % 256, REM_C = ((MT / 256) * (NGU / 256)) % 256;

#ifndef NRM_NT
#define NRM_NT 0
#endif
#if NRM_NT
#define NRM_LD(p) __builtin_nontemporal_load(p)
#define NRM_ST(p, v) __builtin_nontemporal_store((v), (p))
#else
#define NRM_LD(p) (*(p))
#define NRM_ST(p, v) (*(p) = (v))
#endif
template <bool HAS_MF, bool XIN16, bool XOUT16>
__device__ __forceinline__ void norm_rows(const bool HAS_NEXT, const float* xp_in, bf16* xb, const bf16* mf, const float* gpost, float* xout, float* rs, int bx, int wave, int lane_in) {
    f32x4 g[16];
    if (HAS_MF) {
#pragma unroll
        for (int j = 0; j < 16; ++j) g[j] = ((const GAS f32x4*)gpost)[lane_in + 64 * j];
    }
#pragma unroll 1
    for (int it = 0; it < 4; ++it) {
        const int row = (bx * NWAVES + wave) + it * 2048;
        int lane = lane_in; asm volatile("" : "+v"(lane));
        f32x4 x[16]; v2u xx[16], mm[16];
        if (XIN16) {
#pragma unroll
            for (int j = 0; j < 16; ++j) xx[j] = NRM_LD(((const GAS v2u*)(xb + (size_t)row * DM)) + lane + 64 * j);
        } else {
#pragma unroll
            for (int j = 0; j < 16; ++j) x[j] = NRM_LD(((const GAS f32x4*)(xp_in + (size_t)row * DM)) + lane + 64 * j);
        }
        if (HAS_MF) {
#pragma unroll
            for (int j = 0; j < 16; ++j) mm[j] = NRM_LD(((const GAS v2u*)(mf + (size_t)row * DM)) + lane + 64 * j);
        }
        if (XIN16) {
#pragma unroll
            for (int j = 0; j < 16; ++j) x[j] = (f32x4){bflo(xx[j].x), bfhi(xx[j].x), bflo(xx[j].y), bfhi(xx[j].y)};
        }
        if (HAS_MF) {
            float ss = 0.f;
#pragma unroll
            for (int j = 0; j < 16; ++j) { const float a = bflo(mm[j].x), b = bfhi(mm[j].x), c = bflo(mm[j].y), d = bfhi(mm[j].y); ss += (a * a + b * b) + (c * c + d * d); }
            const float r1 = 1.0f / sqrtf(wave_sum(ss) * (1.0f / DM) + EPS);
#pragma unroll
            for (int j = 0; j < 16; ++j) { const f32x4 m = (f32x4){bflo(mm[j].x), bfhi(mm[j].x), bflo(mm[j].y), bfhi(mm[j].y)};
                x[j] += m * r1 * g[j]; }
        }
        if (XOUT16) {
#pragma unroll
            for (int j = 0; j < 16; ++j) { v2u o; o.x = cvtpk(x[j][0], x[j][1]); o.y = cvtpk(x[j][2], x[j][3]); NRM_ST(((GAS v2u*)(xb + (size_t)row * DM)) + lane + 64 * j, o); }
        } else {
#pragma unroll
            for (int j = 0; j < 16; ++j) ((GAS f32x4*)(xout + (size_t)row * DM))[lane + 64 * j] = x[j];
        }
        if (HAS_NEXT) {
            float s2 = 0.f;
#pragma unroll
            for (int j = 0; j < 16; ++j) s2 += (x[j][0] * x[j][0] + x[j][1] * x[j][1]) + (x[j][2] * x[j][2] + x[j][3] * x[j][3]);
            const float r2 = 1.0f / sqrtf(wave_sum(s2) * (1.0f / DM) + EPS);
            if (lane == 0) rs[row] = r2;
        }
    }
}

template <bool HAS_MF, bool XIN16, bool XOUT16>
__device__ __forceinline__ void norm_sample_row(const bool HAS_NEXT, const float* xs_in, bf16* xb, const bf16* slabs, const float* gpost, float* xout, float* rs, LAS float* red, int bx, int tid) {
    const int col = tid * 8, wave = tid >> 6, lane = tid & 63;
    const size_t ro = (size_t)bx * DM + col;
    f32x4 x0, x1;
    if (XIN16) { const v4u xx = *(const GAS v4u*)(xb + (size_t)NPR * DM + ro); x0 = (f32x4){bflo(xx.x), bfhi(xx.x), bflo(xx.y), bfhi(xx.y)}; x1 = (f32x4){bflo(xx.z), bfhi(xx.z), bflo(xx.w), bfhi(xx.w)}; }
    else { x0 = *(const GAS f32x4*)(xs_in + ro); x1 = *(const GAS f32x4*)(xs_in + ro + 4); }
    if (HAS_MF) {
        f32x4 m0 = {0.f, 0.f, 0.f, 0.f}, m1 = m0;
        v4u sl[16];
#pragma unroll
        for (int s = 0; s < 16; ++s) sl[s] = *(const GAS v4u*)(slabs + (size_t)s * NSM * DM + ro);
#pragma unroll
        for (int s = 0; s < 16; ++s) { m0 += (f32x4){bflo(sl[s].x), bfhi(sl[s].x), bflo(sl[s].y), bfhi(sl[s].y)}; m1 += (f32x4){bflo(sl[s].z), bfhi(sl[s].z), bflo(sl[s].w), bfhi(sl[s].w)}; }
        float ss = (m0[0] * m0[0] + m0[1] * m0[1]) + (m0[2] * m0[2] + m0[3] * m0[3]) + (m1[0] * m1[0] + m1[1] * m1[1]) + (m1[2] * m1[2] + m1[3] * m1[3]);
        ss = wave_sum(ss);
        if (lane == 0) red[wave] = ss;
        __syncthreads();
        float tot = 0.f;
#pragma unroll
        for (int w = 0; w < 8; ++w) tot += red[w];
        const float r1 = 1.0f / sqrtf(tot * (1.0f / DM) + EPS);
        const f32x4 g0 = *(const GAS f32x4*)(gpost + col), g1 = *(const GAS f32x4*)(gpost + col + 4);
        x0 += m0 * r1 * g0; x1 += m1 * r1 * g1;
    }
    if (XOUT16) { v4u o; o.x = cvtpk(x0[0], x0[1]); o.y = cvtpk(x0[2], x0[3]); o.z = cvtpk(x1[0], x1[1]); o.w = cvtpk(x1[2], x1[3]); *(GAS v4u*)(xb + (size_t)NPR * DM + ro) = o; }
    else { *(GAS f32x4*)(xout + (size_t)NPR * DM + ro) = x0; *(GAS f32x4*)(xout + (size_t)NPR * DM + ro + 4) = x1; }
    if (HAS_NEXT) {
        float s2 = (x0[0] * x0[0] + x0[1] * x0[1]) + (x0[2] * x0[2] + x0[3] * x0[3]) + (x1[0] * x1[0] + x1[1] * x1[1]) + (x1[2] * x1[2] + x1[3] * x1[3]);
        s2 = wave_sum(s2);
        if (lane == 0) red[8 + wave] = s2;
        __syncthreads();
        float tot = 0.f;
#pragma unroll
        for (int w = 0; w < 8; ++w) tot += red[8 + w];
        if (tid == 0) rs[NPR + bx] = 1.0f / sqrtf(tot * (1.0f / DM) + EPS);
    }
    __syncthreads();
}

constexpr int KS_STRIDE = 144, VT_STRIDE = 528, ATT_VT_OFF = 256 * KS_STRIDE;
#define MFMA32(a, b, c) __builtin_amdgcn_mfma_f32_32x32x16_bf16((a), (b), (c), 0, 0, 0)
__device__ __forceinline__ void attn_loadq(bf16x8 (&qf)[4], const bf16* qptr, int lane) {
    const int hi = lane >> 5;
#pragma unroll
    for (int ks = 0; ks < 4; ++ks) qf[ks] = *(const GAS bf16x8*)(qptr + ks * 16 + hi * 8);
}
__device__ __forceinline__ void attn_item(const LAS unsigned char* Ks, const LAS unsigned char* Vt, const bf16x8 (&qf)[4], int qi, float sink, bf16* optr, int kb0, bool n0, int lane) {
    const int r32 = lane & 31, hi = lane >> 5;
    f32x16 s[5];
#pragma unroll
    for (int kk = 0; kk < 5; ++kk) { f32x16 a = {};
#pragma unroll
        for (int ks = 0; ks < 4; ++ks) { const bf16x8 kf = *(const LAS bf16x8*)(Ks + (32 * (kb0 + kk) + r32) * KS_STRIDE + (16 * ks + 8 * hi) * 2); a = MFMA32(kf, qf[ks], a); }
        s[kk] = a; }
    float mx = sink;
#pragma unroll
    for (int kk = 0; kk < 5; ++kk)
#pragma unroll
        for (int r = 0; r < 16; ++r) { const int j = 32 * (kb0 + kk) + crow(r, hi); const bool ok = (j > qi) && (j <= qi + 128) && (!n0 || j >= 128);
            const float v = ok ? s[kk][r] : -INFINITY; s[kk][r] = v; mx = fmaxf(mx, v); }
    mx = fmaxf(mx, __shfl_xor(mx, 32));
    float l = 0.f;
#pragma unroll
    for (int kk = 0; kk < 5; ++kk)
#pragma unroll
        for (int r = 0; r < 16; ++r) { const float p = __builtin_amdgcn_exp2f((s[kk][r] - mx) * LOG2E); s[kk][r] = p; l += p; }
    l += __shfl_xor(l, 32);
    l += __builtin_amdgcn_exp2f((sink - mx) * LOG2E);
    f32x16 o[2] = {{}, {}};
#pragma unroll
    for (int kk = 0; kk < 5; ++kk)
#pragma unroll
        for (int si = 0; si < 2; ++si) { v4u pw; pw.x = cvtpk(s[kk][8 * si + 0], s[kk][8 * si + 1]); pw.y = cvtpk(s[kk][8 * si + 2], s[kk][8 * si + 3]); pw.z = cvtpk(s[kk][8 * si + 4], s[kk][8 * si + 5]); pw.w = cvtpk(s[kk][8 * si + 6], s[kk][8 * si + 7]);
            const bf16x8 pf = __builtin_bit_cast(bf16x8, pw);
#pragma unroll
            for (int db = 0; db < 2; ++db) { const LAS unsigned char* vp = Vt + (32 * db + r32) * VT_STRIDE + (32 * (kb0 + kk) + 16 * si + 4 * hi) * 2;
                const v2u lo = *(const LAS v2u*)vp, hh = *(const LAS v2u*)(vp + 16);
                v4u vw; vw.x = lo.x; vw.y = lo.y; vw.z = hh.x; vw.w = hh.y;
                o[db] = MFMA32(__builtin_bit_cast(bf16x8, vw), pf, o[db]); } }
    const float inv = 1.0f / l;
#pragma unroll
    for (int db = 0; db < 2; ++db)
#pragma unroll
        for (int g4 = 0; g4 < 4; ++g4) { v2u w; w.x = cvtpk(o[db][4 * g4 + 0] * inv, o[db][4 * g4 + 1] * inv); w.y = cvtpk(o[db][4 * g4 + 2] * inv, o[db][4 * g4 + 3] * inv);
            *(GAS v2u*)(optr + 32 * db + 8 * g4 + 4 * hi) = w; }
}
__device__ __forceinline__ void vt_scatter(LAS unsigned char* Vt, int part, int key, v4u vv) {
#pragma unroll
    for (int e = 0; e < 8; ++e) { const unsigned w = vv[e >> 1]; *(LAS unsigned short*)(Vt + (part * 8 + e) * VT_STRIDE + key * 2) = (unsigned short)((e & 1) ? (w >> 16) : (w & 0xffffu)); }
}
__device__ __forceinline__ void attn_unit_prompt(LAS unsigned char* lds, const bf16* Z, bf16* MIX, const float* sinks, int unit, int tid, int wave, int lane) {
    const int kvh = unit & 3, n = (unit >> 2) & 15, b = unit >> 6;
    LAS unsigned char* Ks = lds; LAS unsigned char* Vt = lds + ATT_VT_OFF;
    const int keyrow0 = b * SEQL + 128 * (n - 1); const bool n0 = (n == 0);
#pragma unroll
    for (int i = 0; i < 4; ++i) { const int c = tid + 512 * i, key = c >> 3, part = c & 7;
        v4u kv = {0u, 0u, 0u, 0u}, vv = {0u, 0u, 0u, 0u};
        if (!(n0 && key < 128)) { const bf16* zr = Z + (size_t)(keyrow0 + key) * INC + kvh * 64 + part * 8; kv = *(const GAS v4u*)(zr + COL_K); vv = *(const GAS v4u*)(zr + COL_V); }
        *(LAS v4u*)(Ks + key * KS_STRIDE + part * 16) = kv; vt_scatter(Vt, part, key, vv); }
    __syncthreads();
    const int head = kvh * 8 + wave; const float sink = sinks[head];
    const size_t row0 = (size_t)b * SEQL + 128 * n + (lane & 31);
    bf16x8 qa[4], qb_[4];
    attn_loadq(qa, Z + row0 * INC + head * 64, lane);
#pragma unroll 1
    for (int qb = 0; qb < 4; qb += 2) {
        attn_loadq(qb_, Z + (row0 + 32 * (qb + 1)) * INC + head * 64, lane);
        attn_item(Ks, Vt, qa, 32 * qb + (lane & 31), sink, MIX + (row0 + 32 * qb) * DM + head * 64, qb, n0, lane);
        if (qb + 2 < 4) attn_loadq(qa, Z + (row0 + 32 * (qb + 2)) * INC + head * 64, lane);
        attn_item(Ks, Vt, qb_, 32 * (qb + 1) + (lane & 31), sink, MIX + (row0 + 32 * (qb + 1)) * DM + head * 64, qb + 1, n0, lane); }
    __syncthreads();
}
__device__ __forceinline__ void attn_unit_sample(LAS unsigned char* lds, const bf16* Z, bf16* MIX, const float* sinks, const float* stk, const float* stv  , int unit, int tid, int wave, int lane) {
    const int kvh = unit & 3, bs = unit >> 2;
    LAS unsigned char* Ks = lds; LAS unsigned char* Vt = lds + ATT_VT_OFF;
    for (int c = tid; c < 160 * 8; c += 512) { const int key = c >> 3, part = c & 7;
        v4u kv = {0u, 0u, 0u, 0u}, vv = {0u, 0u, 0u, 0u};
        if (key < 128) { const size_t o = (((size_t)bs * 128 + key) * 4 + kvh) * 64 + part * 8;
            const f32x4 k0 = *(const GAS f32x4*)(stk + o), k1 = *(const GAS f32x4*)(stk + o + 4), v0 = *(const GAS f32x4*)(stv + o), v1 = *(const GAS f32x4*)(stv + o + 4);
            kv.x = cvtpk(k0[0], k0[1]); kv.y = cvtpk(k0[2], k0[3]); kv.z = cvtpk(k1[0], k1[1]); kv.w = cvtpk(k1[2], k1[3]);
            vv.x = cvtpk(v0[0], v0[1]); vv.y = cvtpk(v0[2], v0[3]); vv.z = cvtpk(v1[0], v1[1]); vv.w = cvtpk(v1[2], v1[3]); }
        else if (key < 136) { const bf16* zr = Z + (size_t)(NPR + bs * DSEQ + (key - 128)) * INC + kvh * 64 + part * 8; kv = *(const GAS v4u*)(zr + COL_K); vv = *(const GAS v4u*)(zr + COL_V); }
        *(LAS v4u*)(Ks + key * KS_STRIDE + part * 16) = kv; vt_scatter(Vt, part, key, vv); }
    __syncthreads();
    if (wave < 2) { const int q = lane & 31, head = kvh * 8 + wave * 4 + (q >> 3), t = q & 7; const size_t row = (size_t)NPR + bs * DSEQ + t;
        bf16x8 qs[4]; attn_loadq(qs, Z + row * INC + head * 64, lane);
        attn_item(Ks, Vt, qs, t, sinks[head], MIX + row * DM + head * 64, 0, false, lane); }
    __syncthreads();
}
constexpr int VN_STRIDE = 272, GM_RS_OFF = 128 * VN_STRIDE;
struct GmlpRaw { v4u raw[4]; f32x4 g0, g1; };
__device__ __forceinline__ void gmlp_issue(GmlpRaw& R, const bf16* Z, const float* gnorm, int unit, int tid) {
    const int hh = unit & 15, R0 = (unit >> 4) * 128;
#pragma unroll
    for (int i = 0; i < 4; ++i) { const int c = tid + 512 * i, s = c >> 4, ep = c & 15; R.raw[i] = *(const GAS v4u*)(Z + (size_t)(R0 + s) * INC + COL_GV + hh * 128 + ep * 8); }
    const int ep = tid & 15;
    R.g0 = *(const GAS f32x4*)(gnorm + hh * 128 + ep * 8); R.g1 = *(const GAS f32x4*)(gnorm + hh * 128 + ep * 8 + 4);
}
__device__ __forceinline__ void gmlp_finish(const GmlpRaw& R, LAS unsigned char* lds, const bf16* Z, bf16* MIX, const float* ssq, const bf16* wtril, const float* gbias, int unit, bool need_rs, int tid, int wave, int lane) {
    const int hh = unit & 15, R0 = (unit >> 4) * 128;
    LAS unsigned char* vnT = lds; LAS float* rsl = (LAS float*)(lds + GM_RS_OFF);
    const int r32 = lane & 31, hi = lane >> 5, tb = wave >> 1, eb0 = (wave & 1) * 2, t = 32 * tb + r32;
    const int ep = tid & 15, nks = 2 * tb + 2;
    const bf16* wrow = wtril + ((size_t)hh * 128 + t) * 128;
    bf16x8 wf[8];
#pragma unroll
    for (int ks = 0; ks < 8; ++ks) wf[ks] = (ks < nks) ? *(const GAS bf16x8*)(wrow + 16 * ks + 8 * hi) : (bf16x8){0, 0, 0, 0, 0, 0, 0, 0};
    const float bias = gbias[hh * 128 + t];
    const bf16* urow = Z + (size_t)(R0 + t) * INC + COL_U + hh * 128; bf16* orow = MIX + (size_t)(R0 + t) * DM + QCOLS + hh * 128;
    v2u uu[2][4];
#pragma unroll
    for (int eb = 0; eb < 2; ++eb)
#pragma unroll
        for (int g4 = 0; g4 < 4; ++g4) uu[eb][g4] = *(const GAS v2u*)(urow + 32 * (eb0 + eb) + 8 * g4 + 4 * hi);
    if (need_rs) {
        if (tid < 128) { const GAS f32x4* p = (const GAS f32x4*)(ssq + (size_t)(R0 + tid) * 32); f32x4 v[8];
#pragma unroll
            for (int i = 0; i < 8; ++i) v[i] = p[i];
            float s = 0.f;
#pragma unroll
            for (int i = 0; i < 8; ++i) s += (v[i][0] + v[i][1]) + (v[i][2] + v[i][3]);
            rsl[tid] = 1.0f / sqrtf(s * (1.0f / GMW) + EPS); }
        __syncthreads();
    }
#pragma unroll
    for (int i = 0; i < 4; ++i) { const int c = tid + 512 * i, s = c >> 4;
        const float rs = rsl[s];
        const unsigned p0 = cvtpk(bflo(R.raw[i].x) * rs * R.g0[0], bfhi(R.raw[i].x) * rs * R.g0[1]), p1 = cvtpk(bflo(R.raw[i].y) * rs * R.g0[2], bfhi(R.raw[i].y) * rs * R.g0[3]);
        const unsigned p2 = cvtpk(bflo(R.raw[i].z) * rs * R.g1[0], bfhi(R.raw[i].z) * rs * R.g1[1]), p3 = cvtpk(bflo(R.raw[i].w) * rs * R.g1[2], bfhi(R.raw[i].w) * rs * R.g1[3]);
        LAS unsigned short* d = (LAS unsigned short*)(vnT + (ep * 8) * VN_STRIDE + s * 2);
        d[0 * 136] = (unsigned short)(p0 & 0xffffu); d[1 * 136] = (unsigned short)(p0 >> 16); d[2 * 136] = (unsigned short)(p1 & 0xffffu); d[3 * 136] = (unsigned short)(p1 >> 16);
        d[4 * 136] = (unsigned short)(p2 & 0xffffu); d[5 * 136] = (unsigned short)(p2 >> 16); d[6 * 136] = (unsigned short)(p3 & 0xffffu); d[7 * 136] = (unsigned short)(p3 >> 16); }
    __syncthreads();
    f32x16 a0 = {}, a1 = {};
#pragma unroll
    for (int ks = 0; ks < 8; ++ks) { if (ks < nks) {
        const bf16x8 v0 = *(const LAS bf16x8*)(vnT + (32 * eb0 + r32) * VN_STRIDE + (16 * ks + 8 * hi) * 2), v1 = *(const LAS bf16x8*)(vnT + (32 * (eb0 + 1) + r32) * VN_STRIDE + (16 * ks + 8 * hi) * 2);
        a0 = MFMA32(v0, wf[ks], a0); a1 = MFMA32(v1, wf[ks], a1); } }
#pragma unroll
    for (int eb = 0; eb < 2; ++eb)
#pragma unroll
        for (int g4 = 0; g4 < 4; ++g4) { const int e0 = 32 * (eb0 + eb) + 8 * g4 + 4 * hi; const v2u u2 = uu[eb][g4];
            const float s0 = (eb ? a1[4 * g4 + 0] : a0[4 * g4 + 0]) + bias, s1 = (eb ? a1[4 * g4 + 1] : a0[4 * g4 + 1]) + bias, s2 = (eb ? a1[4 * g4 + 2] : a0[4 * g4 + 2]) + bias, s3 = (eb ? a1[4 * g4 + 3] : a0[4 * g4 + 3]) + bias;
            v2u w; w.x = cvtpk(bflo(u2.x) * s0, bfhi(u2.x) * s1); w.y = cvtpk(bflo(u2.y) * s2, bfhi(u2.y) * s3);
            *(GAS v2u*)(orow + e0) = w; }
    __syncthreads();
}
__device__ __forceinline__ void gmlp_sample_item(LAS unsigned char* lds, const bf16* Z, bf16* MIX, const float* ssq, const float* gnorm, const float* wsp  , const float* gbias, float* out_sg, int item, int tid) {
    const int bs = item >> 3, part = item & 7;
    LAS float* rsl = (LAS float*)lds;
    if (tid < 8) { const GAS f32x4* p = (const GAS f32x4*)(ssq + (size_t)(NPR + bs * DSEQ + tid) * 32); float s = 0.f;
#pragma unroll
        for (int i = 0; i < 8; ++i) { const f32x4 v = p[i]; s += (v[0] + v[1]) + (v[2] + v[3]); }
        rsl[tid] = 1.0f / sqrtf(s * (1.0f / GMW) + EPS); }
    __syncthreads();
    const int t = tid >> 6, col = part * 256 + (tid & 63) * 4, hh = col >> 7;
    const f32x4 g = *(const GAS f32x4*)(gnorm + col);
    f32x4 acc = {0.f, 0.f, 0.f, 0.f};
    const float* wr = wsp + ((size_t)hh * 128 + t) * 128;
    v2u rawv[8]; float wv[8];
#pragma unroll
    for (int s = 0; s < 8; ++s) { if (s <= t) { rawv[s] = *(const GAS v2u*)(Z + ((size_t)NPR + bs * DSEQ + s) * INC + COL_GV + col); wv[s] = wr[s]; } else { rawv[s] = (v2u){0u, 0u}; wv[s] = 0.f; } }
#pragma unroll
    for (int s = 0; s < 8; ++s) { if (s <= t) { const float rs = rsl[s];
        f32x4 vn; vn[0] = bflo(rawv[s].x) * rs * g[0]; vn[1] = bfhi(rawv[s].x) * rs * g[1]; vn[2] = bflo(rawv[s].y) * rs * g[2]; vn[3] = bfhi(rawv[s].y) * rs * g[3];
        acc += vn * wv[s];
        if (s == t) *(GAS f32x4*)(out_sg + (size_t)(bs * DSEQ + t) * GMW + col) = vn; } }
    const float bias = gbias[hh * 128 + t];
    const size_t row = (size_t)NPR + bs * DSEQ + t; const v2u uu = *(const GAS v2u*)(Z + row * INC + COL_U + col);
    v2u w; w.x = cvtpk(bflo(uu.x) * (acc[0] + bias), bfhi(uu.x) * (acc[1] + bias)); w.y = cvtpk(bflo(uu.y) * (acc[2] + bias), bfhi(uu.y) * (acc[3] + bias));
    *(GAS v2u*)(MIX + row * DM + QCOLS + col) = w;
    __syncthreads();
}

__device__ __forceinline__ int idle_rank(pg8::StaticOrder S, int rnd, int bx, int lane, int& n_idle) {
    int rank = 0; n_idle = 0;
#pragma unroll
    for (int k = 0; k < 4; ++k) { S.c = lane + 64 * k; pg8::Unit u; const bool busy = S.next(rnd, u);
        const unsigned long long m = __ballot(!busy);
        n_idle += __popcll(m);
        if (bx >= 64 * (k + 1)) rank += __popcll(m); else if (bx >= 64 * k) rank += __popcll(m & ((1ull << (bx - 64 * k)) - 1ull)); }
    return rank;
}
#ifndef CVQ
#define CVQ 0
#endif
constexpr int CW_QHEAD = 8192, CW_QDONE = 8192 + 64;
__device__ __forceinline__ void cvt_queue(const float* const* in, unsigned char* ws, gu32* ctl, int p, int n_busy, int hard, LAS unsigned char* scr, int lane) {
    gu32* head = ctl + CW_QHEAD; gu32* done = ctl + CW_QDONE + 64 * p;
#pragma unroll 1
    for (;;) {
        unsigned d = 0, h = 0;
        if (lane == 0) { d = __hip_atomic_load(done, RLX_AGENT); h = __hip_atomic_load(head, RLX_AGENT); }
        d = (unsigned)__builtin_amdgcn_readfirstlane((int)d); h = (unsigned)__builtin_amdgcn_readfirstlane((int)h);
        const bool running = d < (unsigned)n_busy;
        const int cur = CJ_P1 + (int)h;
        if (cur >= I_ALL) break;
        if (!running && cur >= hard) break;
        const int qb = running ? 2 : 1;
        unsigned t = 0; if (lane == 0) t = __hip_atomic_fetch_add(head, (unsigned)qb, RLX_AGENT);
        t = (unsigned)__builtin_amdgcn_readfirstlane((int)t);
        const int id = CJ_P1 + (int)t; if (id >= I_ALL) break;
        cvt_range(in, ws, id, id + qb < I_ALL ? id + qb : I_ALL, 0, 1, scr, lane);
    }
}
struct Args { const float* in[20]; float* out; unsigned char* ws; int ph_lo, ph_hi; };
constexpr int N_PHASES = 1 + 8 * NLAYER;
__global__ void __launch_bounds__(NWAVES * 64, 2) fwd_kernel(Args args) {
    extern __shared__ __attribute__((aligned(16))) unsigned char lds_raw[];
    LAS unsigned char* lds = (LAS unsigned char*)lds_raw;
    volatile LAS unsigned* MISC = (volatile LAS unsigned*)(lds + MISC_OFF);
    constexpr int G = 256;
    const int bx = blockIdx.x; constexpr int NGW = G * NWAVES;
    __builtin_assume(bx >= 0 && bx < G);
    const int wave0 = __builtin_amdgcn_readfirstlane((int)threadIdx.x >> 6);
    unsigned char* ws = args.ws;
    gu32* ctl = (gu32*)(ws + WS_CTL);
    for (int u = threadIdx.x; u < (LDS_BYTES - LDSCTL_OFF) / 4; u += NWAVES * 64) ((LAS unsigned*)(lds + LDSCTL_OFF))[u] = 0u;
    __syncthreads();
    XcdBarrier bar; bar.bar = (unsigned*)(ctl + CW_BAR); bar.x = 0; bar.st = nullptr;
    if (!MK_PER_PHASE) bar = xcd_barrier_post((unsigned*)(ctl + CW_BAR), MISC + 8);
#if MK_PER_PHASE
    const int lo = args.ph_lo, hi = args.ph_hi;
#else
    constexpr int lo = 0, hi = N_PHASES;
#endif
#define IN(k) (lo <= (k) && (k) < hi)
#define PHASE_IDS int wv_p = wave0; asm volatile("" : "+s"(wv_p)); int ln_p; asm volatile("v_mbcnt_lo_u32_b32 %0, -1, 0\n\tv_mbcnt_hi_u32_b32 %0, -1, %0" : "=v"(ln_p)); const int tid = wv_p * 64 + ln_p, lane = tid & 63, wave = __builtin_amdgcn_readfirstlane(tid >> 6), gw = bx * NWAVES + wave; (void)lane; (void)gw; (void)wave; (void)tid
#define SEAM(k) do { if (IN(k) && IN((k) + 1)) xcd_barrier(bar); } while (0)

    const float* x_prompt = args.in[0]; const float* x_sample = args.in[1];
    float* out = args.out;
    bf16* Hb = (bf16*)(ws + WS_H); bf16* Zb = (bf16*)(ws + WS_Z); bf16* MIXb = (bf16*)(ws + WS_MIX); bf16* Ab = (bf16*)(ws + WS_A); bf16* MFb = (bf16*)(ws + WS_MF);
    float* SSQ = (float*)(ws + WS_SSQ); bf16* HALO = (bf16*)(ws + WS_HALO); bf16* SLAB = (bf16*)(ws + WS_SLAB); bf16* XB = (bf16*)(ws + WS_XB); float* RS = (float*)(ws + WS_RS); bf16* TRIL = (bf16*)(ws + WS_TRIL);

    for (int rep = 0; rep < (RP(0) ? 2 : 1); ++rep) { if (rep) xcd_barrier(bar);
    if (IN(0) && !SK(0)) {
        { PHASE_IDS;
        LAS unsigned char* scr = lds + RING_OFF + wave * CVT_SCR;
#ifndef PRO_REV
#define PRO_REV 0
#endif
        cvt_range(args.in, ws, 0, CJ_P1, gw, NGW, scr, lane, PRO_REV != 0);
        if (CJ_P2 > CJ_E1) cvt_range(args.in, ws, CJ_E1, CJ_P2, gw, NGW, scr, lane);
        }
        PHASE_IDS;
        for (int i = bx * 512 + tid; i < NLAYER * 16 * 128 * 128 / 4; i += G * 512) { const f32x4 v = ((const GAS f32x4*)args.in[8])[i]; const int s0 = (i * 4) & 127, t = ((i * 4) >> 7) & 127;
            v2u o; o.x = cvtpk(s0 + 0 <= t ? v[0] : 0.f, s0 + 1 <= t ? v[1] : 0.f); o.y = cvtpk(s0 + 2 <= t ? v[2] : 0.f, s0 + 3 <= t ? v[3] : 0.f); ((GAS v2u*)TRIL)[i] = o; }
        norm_sample_row<false, false, true>(true, x_sample, XB, nullptr, nullptr, nullptr, RS, (LAS float*)(lds + 81920), bx, tid);
        norm_rows<false, false, true>(true, x_prompt, XB, nullptr, nullptr, nullptr, RS, bx, wave, lane);
    } }
    SEAM(0);
#pragma unroll 1
    for (int l = 0; l < NLAYER; ++l) {
        const int pb = 1 + 8 * l;
        unsigned char* wl = ws + WS_W + (size_t)l * WL_STRIDE;
        for (int rep = 0; rep < ((RP(1) && l == 0) ? 2 : 1); ++rep) { if (rep) xcd_barrier(bar);
        if (IN(pb + 0) && !SK(1)) {
            pg8::Gemm g{XB, (const bf16*)(wl + WL_IN), MT, INC, DM}; pg8::StaticOrder S; S.init(MT, INC, G, bx, DM);
            pg8::EpiIn E{Zb, SSQ, out + O_PK + (size_t)l * 131072, out + O_PV + (size_t)l * 131072, out + O_SK + (size_t)l * 65536, out + O_SV + (size_t)l * 65536, RS, lds + LDSCTL_OFF + 1024};
            pg8::gemm_phase<pg8::EpiIn, pg8::StaticOrder, PG8_ALIGN, PG8_SP2>(lds + RING_OFF, g, S, E, wave0);
#if CVQ
            { PHASE_IDS; pg8::Unit u_; if (S.next(3, u_) && tid == 0) __hip_atomic_fetch_add(ctl + CW_QDONE + 64 * (2 * l), 1u, RLX_AGENT);
              cvt_queue(args.in, ws, ctl, 2 * l, REM_A, l == 0 ? I_IN + I_OUT + 2 * I_G : CJ_E1, lds + RING_OFF + wave * CVT_SCR, lane); }
#else
            { pg8::Unit u_; if (!S.next(3, u_)) { PHASE_IDS; int n_idle; const int rk = idle_rank(S, 3, bx, lane, n_idle); cvt_range(args.in, ws, l == 0 ? CJ_P1 : CJ_C0, l == 0 ? CJ_A0 : CJ_E1, rk * NWAVES + wave, n_idle * NWAVES, lds + RING_OFF + wave * CVT_SCR, lane); } }
#endif
        }
        }
        SEAM(pb + 0);
        for (int rep = 0; rep < ((RP(2) && l == 0) ? 2 : 1); ++rep) { if (rep) xcd_barrier(bar);
        if (IN(pb + 1) && !SK(2)) {
            const float* sinks = args.in[7] + l * 32;
            const float* gnorm = args.in[10] + l * GMW; const float* gbias = args.in[9] + l * 2048; const bf16* wtril = TRIL + (size_t)l * 16 * 128 * 128;
            { PHASE_IDS;
            for (int u = bx; u < 256; u += G) attn_unit_prompt(lds, Zb, MIXb, sinks, u, tid, wave, lane);
            { GmlpRaw Ra, Rb;
              const int u0 = bx * 4;
              gmlp_issue(Ra, Zb, gnorm, u0, tid);
              gmlp_issue(Rb, Zb, gnorm, u0 + 1, tid); gmlp_finish(Ra, lds, Zb, MIXb, SSQ, wtril, gbias, u0, true, tid, wave, lane);
              gmlp_issue(Ra, Zb, gnorm, u0 + 2, tid); gmlp_finish(Rb, lds, Zb, MIXb, SSQ, wtril, gbias, u0 + 1, false, tid, wave, lane);
              gmlp_issue(Rb, Zb, gnorm, u0 + 3, tid); gmlp_finish(Ra, lds, Zb, MIXb, SSQ, wtril, gbias, u0 + 2, false, tid, wave, lane);
              gmlp_finish(Rb, lds, Zb, MIXb, SSQ, wtril, gbias, u0 + 3, false, tid, wave, lane); }
            }
            { PHASE_IDS;
            const float* stk = args.in[2] + (size_t)l * DBATCH * 128 * 256; const float* stv = args.in[3] + (size_t)l * DBATCH * 128 * 256;
            for (int u = bx; u < 128; u += G) attn_unit_sample(lds, Zb, MIXb, sinks, stk, stv, u, tid, wave, lane);
            for (int it = bx; it < 256; it += G) gmlp_sample_item(lds, Zb, MIXb, SSQ, gnorm, args.in[8] + (size_t)l * 16 * 128 * 128, gbias, out + O_SG + (size_t)l * NSM * GMW, it, tid);
            }
        }
        }
        SEAM(pb + 1);
        for (int rep = 0; rep < ((RP(3) && l == 0) ? 2 : 1); ++rep) { if (rep) xcd_barrier(bar);
        if (IN(pb + 2) && !SK(3)) {
            pg8::Gemm g{MIXb, (const bf16*)(wl + WL_OUT), MT, DM, DM}; pg8::SplitOrder S; S.init2(NPR, DM, G, bx, DM);
            pg8::EpiPlain E{MFb, DM, SLAB};
            pg8::gemm_phase<pg8::EpiPlain, pg8::SplitOrder, PG8_ALIGN, PG8_SP2>(lds + RING_OFF, g, S, E, wave0);
        }
        }
        SEAM(pb + 2);
        for (int rep = 0; rep < ((RP(4) && l == 0) ? 2 : 1); ++rep) { if (rep) xcd_barrier(bar);
        if (IN(pb + 3) && !SK(4)) { PHASE_IDS;
            norm_sample_row<true, true, true>(true, nullptr, XB, SLAB, args.in[12] + l * DM, nullptr, RS, (LAS float*)(lds + 81920), bx, tid);
            norm_rows<true, true, true>(true, nullptr, XB, MFb, args.in[12] + l * DM, nullptr, RS, bx, wave, lane);
        }
        }
        SEAM(pb + 3);
        for (int rep = 0; rep < ((RP(5) && l == 0) ? 2 : 1); ++rep) { if (rep) xcd_barrier(bar);
        if (IN(pb + 4) && !SK(5)) {
            pg8::Gemm g{XB, (const bf16*)(wl + WL_GU), MT, NGU, DM}; pg8::StaticOrder S; S.init(MT, NGU, G, bx, DM);
            pg8::EpiGU E{Ab, HALO, args.in[18] + (size_t)l * 3 * FFN, args.in[19] + (size_t)l * FFN, args.in[4] + (size_t)l * DBATCH * 2 * FFN, out + O_PC + (size_t)l * NBATCH * 2 * FFN, out + O_SC + (size_t)l * DBATCH * 2 * FFN, lds + LDSCTL_OFF + 1024, RS};
            pg8::gemm_phase<pg8::EpiGU, pg8::StaticOrder, PG8_ALIGN, PG8_SP2>(lds + RING_OFF, g, S, E, wave0);
#if CVQ
            { PHASE_IDS; pg8::Unit u_; if (S.next(11, u_) && tid == 0) __hip_atomic_fetch_add(ctl + CW_QDONE + 64 * (2 * l + 1), 1u, RLX_AGENT);
              cvt_queue(args.in, ws, ctl, 2 * l + 1, REM_C, l == 0 ? I_LAYER + I_IN + I_OUT : I_ALL, lds + RING_OFF + wave * CVT_SCR, lane); }
#else
            { pg8::Unit u_; if (!S.next(11, u_)) { PHASE_IDS; int n_idle; const int rk = idle_rank(S, 11, bx, lane, n_idle); cvt_range(args.in, ws, l == 0 ? CJ_A0 : CJ_P2, l == 0 ? CJ_C0 : I_ALL, rk * NWAVES + wave, n_idle * NWAVES, lds + RING_OFF + wave * CVT_SCR, lane); } }
#endif
        }
        }
#ifdef PROBE_HOT
        if (l == 0) { xcd_barrier(bar);
            pg8::Gemm g{Hb, (const bf16*)(wl + WL_GU), MT, 512, DM}; pg8::HotOrder S; S.init(MT, 512, G, bx, DM); S.nrounds = PROBE_HOT;
            pg8::EpiPlain E{(bf16*)(ws + WS_END), 512, SLAB};
            pg8::gemm_phase<pg8::EpiPlain, pg8::HotOrder, PG8_ALIGN, PG8_SP2>(lds + RING_OFF, g, S, E, wave0);
        }
#endif
#ifdef PROBE_GU
        if (l == 0) { xcd_barrier(bar);
            pg8::Gemm g{Hb, (const bf16*)(wl + WL_GU), MT, PROBE_GU * 256, DM}; pg8::StaticOrder S; S.init(MT, PROBE_GU * 256, G, bx, DM);
            pg8::EpiPlain E{(bf16*)(ws + WS_END), PROBE_GU * 256, SLAB};
            pg8::gemm_phase<pg8::EpiPlain, pg8::StaticOrder, PG8_ALIGN, PG8_SP2>(lds + RING_OFF, g, S, E, wave0);
        }
#endif
        SEAM(pb + 4);
        for (int rep = 0; rep < ((RP(6) && l == 0) ? 2 : 1); ++rep) { if (rep) xcd_barrier(bar);
        if (IN(pb + 5) && !SK(6)) { PHASE_IDS;
            const float* cw = args.in[18] + (size_t)l * 3 * FFN; const float* cb = args.in[19] + (size_t)l * FFN;
            for (int i = bx * 512 + tid; i < 128 * (FFN / 8); i += G * 512) { const int j = i / (FFN / 8), f = (i - j * (FFN / 8)) * 8;
                const bf16* hb = HALO + (size_t)j * 6 * FFN + f;
                const v4u g0r = *(const GAS v4u*)hb, g1r = *(const GAS v4u*)(hb + FFN), u0r = *(const GAS v4u*)(hb + 2 * FFN), u1r = *(const GAS v4u*)(hb + 3 * FFN);
                v4u q62r = {0u, 0u, 0u, 0u}, q63r = q62r;
                if ((j & 31) != 0) { q62r = *(const GAS v4u*)(hb - 2 * FFN); q63r = *(const GAS v4u*)(hb - FFN); }
                v4u o0, o1;
#pragma unroll
                for (int hf = 0; hf < 2; ++hf) {
#define HX4(R) ((f32x4){bflo(hf ? R.z : R.x), bfhi(hf ? R.z : R.x), bflo(hf ? R.w : R.y), bfhi(hf ? R.w : R.y)})
                    const f32x4 g0 = HX4(g0r), g1 = HX4(g1r), u0 = HX4(u0r), u1 = HX4(u1r), q62 = HX4(q62r), q63 = HX4(q63r);
#undef HX4
                    const int fh = f + 4 * hf;
                    const f32x4 w0 = *(const GAS f32x4*)(cw + fh), w1 = *(const GAS f32x4*)(cw + FFN + fh), w2 = *(const GAS f32x4*)(cw + 2 * FFN + fh), bb = *(const GAS f32x4*)(cb + fh);
                    const f32x4 c0 = w0 * q62 + w1 * q63 + w2 * g0 + bb, c1 = w0 * q63 + w1 * g0 + w2 * g1 + bb;
                    const f32x4 a0 = pg8::gelu4(c0) * u0, a1 = pg8::gelu4(c1) * u1;
                    if (hf == 0) { o0.x = cvtpk(a0[0], a0[1]); o0.y = cvtpk(a0[2], a0[3]); o1.x = cvtpk(a1[0], a1[1]); o1.y = cvtpk(a1[2], a1[3]); }
                    else { o0.z = cvtpk(a0[0], a0[1]); o0.w = cvtpk(a0[2], a0[3]); o1.z = cvtpk(a1[0], a1[1]); o1.w = cvtpk(a1[2], a1[3]); } }
                *(GAS v4u*)(Ab + (size_t)(64 * j) * FFN + f) = o0; *(GAS v4u*)(Ab + (size_t)(64 * j + 1) * FFN + f) = o1; }
        }
        }
        SEAM(pb + 5);
        for (int rep = 0; rep < ((RP(7) && l == 0) ? 2 : 1); ++rep) { if (rep) xcd_barrier(bar);
        if (IN(pb + 6) && !SK(7)) {
            pg8::Gemm g{Ab, (const bf16*)(wl + WL_DN), MT, DM, FFN}; pg8::SplitOrder S; S.init2(NPR, DM, G, bx, FFN);
            pg8::EpiPlain E{MFb, DM, SLAB};
            pg8::gemm_phase<pg8::EpiPlain, pg8::SplitOrder, PG8_ALIGN, PG8_SP2>(lds + RING_OFF, g, S, E, wave0);
        }
        }
        SEAM(pb + 6);
        if (IN(pb + 7) && !SK(8)) { PHASE_IDS;
            if (l + 1 < NLAYER) {
                norm_sample_row<true, true, true>(true, nullptr, XB, SLAB, args.in[14] + l * DM, nullptr, RS, (LAS float*)(lds + 81920), bx, tid);
                norm_rows<true, true, true>(true, nullptr, XB, MFb, args.in[14] + l * DM, nullptr, RS, bx, wave, lane);
            } else {
                norm_sample_row<true, true, false>(false, nullptr, XB, SLAB, args.in[14] + l * DM, out, nullptr, (LAS float*)(lds + 81920), bx, tid);
                norm_rows<true, true, false>(false, nullptr, XB, MFb, args.in[14] + l * DM, out, nullptr, bx, wave, lane);
            }
        }
        if (l + 1 < NLAYER) SEAM(pb + 7);
    }
#undef IN
#undef SEAM
}

extern "C" void kernel_launch(void* const* d_in, const int* in_sizes, int n_in, void* d_out, int out_size, void* d_ws, size_t ws_size, hipStream_t stream) {
    static int grid = 0;
    if (grid == 0) {
        if (n_in != 20 || (size_t)out_size != O_END || ws_size < WS_END) { fprintf(stderr, "kernel_launch: unexpected shapes: n_in %d out %d ws %zu (need %zu)\n", n_in, out_size, ws_size, (size_t)WS_END); grid = -1; return; }
        int dev = 0, cus = 0, per_cu = 0;
        if (hipGetDevice(&dev) != hipSuccess || hipDeviceGetAttribute(&cus, hipDeviceAttributeMultiprocessorCount, dev) != hipSuccess) { grid = -1; return; }
        if (hipFuncSetAttribute((const void*)fwd_kernel, hipFuncAttributeMaxDynamicSharedMemorySize, LDS_BYTES) != hipSuccess) { fprintf(stderr, "kernel_launch: hipFuncSetAttribute failed\n"); grid = -1; return; }
        if (hipOccupancyMaxActiveBlocksPerMultiprocessor(&per_cu, (const void*)fwd_kernel, NWAVES * 64, LDS_BYTES) != hipSuccess || per_cu < 1) fprintf(stderr, "kernel_launch: occupancy query reports %d\n", per_cu);
        (void)hipGetLastError();
        if (cus < 256) { fprintf(stderr, "kernel_launch: built for a 256-CU device, found %d CUs\n", cus); grid = -1; return; }
        grid = 256;
    }
    if (grid < 0) return;
    if (hipMemsetAsync((char*)d_ws + WS_CTL, 0, CTL_ZERO_BYTES, stream) != hipSuccess) return;
    Args a{};
    for (int i = 0; i < 20; ++i) a.in[i] = (const float*)d_in[i];
    a.out = (float*)d_out; a.ws = (unsigned char*)d_ws;
#if MK_PER_PHASE
    for (int p = 0; p < N_PHASES; ++p) { a.ph_lo = p; a.ph_hi = p + 1; hipLaunchKernelGGL(fwd_kernel, dim3(grid), dim3(NWAVES * 64), LDS_BYTES, stream, a); }
#else
    a.ph_lo = 0; a.ph_hi = N_PHASES;
    hipLaunchKernelGGL(fwd_kernel, dim3(grid), dim3(NWAVES * 64), LDS_BYTES, stream, a);
#endif
}
```

```cpp
#define DYN_PIECES 2
#include <hip/hip_runtime.h>
#include <cstdio>
#include <cstdint>
#ifndef PG8_WGM
#define PG8_WGM 8
#endif
#ifndef PG8_XROW
#define PG8_XROW 0
#endif
#ifndef PG8_MERGE_LAST
#define PG8_MERGE_LAST 1
#endif
#ifndef MK_PER_PHASE
#define MK_PER_PHASE 0
#endif
namespace pg8 {
#define PG8_LAS __attribute__((address_space(3)))
typedef unsigned short bf16_t;
typedef short bf16x8 __attribute__((ext_vector_type(8)));
typedef float f32x4 __attribute__((ext_vector_type(4)));
typedef unsigned u32x4 __attribute__((ext_vector_type(4)));
constexpr int BM = 256, BK = 64, HALF = 128, HTB = HALF * BK * 2  , STAGE_BYTES = 8 * HTB, NXCD = 8, WGM = PG8_WGM;

__host__ __device__ __forceinline__ int lds_byte(int r, int c) { const int st = (r >> 4) * 2 + (c >> 5), rr = r & 15, cc = c & 31, ob = rr * 64 + cc * 2; return st * 1024 + (ob ^ (((ob >> 9) & 1) << 5)); }
__host__ __device__ __forceinline__ void stage_rc(int b, int& R, int& C) { const int st = b / 1024, sb = b % 1024, swz = sb ^ (((sb >> 9) & 1) << 5); R = (st >> 1) * 16 + swz / 64; C = (st & 1) * 32 + (swz % 64) / 2; }
__host__ __device__ __forceinline__ int perm32(int rho) { const int n = rho >> 4, i = rho & 15; return 8 * (i >> 2) + 4 * n + (i & 3); }

struct Unit { int pm, pn, kt0, nt, slab; };
struct Gemm { const bf16_t* A; const bf16_t* Bt; int M, N, K; };

struct StaticOrder {
    int nM, nN, nwg, G, c, ntk;
    int i0, imax;
    __host__ __device__ void init(int M, int N, int G_, int c_, int K_) { nM = M / BM; nN = N / BM; nwg = nM * nN; G = G_; c = c_; ntk = K_ / BK; i0 = 0; imax = 1 << 30; }
    __host__ __device__ __forceinline__ bool next(int i, Unit& u) const {
#if PG8_XROW
        u.kt0 = 0; u.nt = ntk; u.slab = -1;
        const int xcd = c & 7, j = c >> 3, mloc = j & 3, nloc = j >> 2, R = (nN + 7) >> 3, f = nN - 8 * (R - 1);
        if (i < R) { const int pn = 8 * i + nloc; if (pn < nN) { u.pm = 4 * xcd + mloc; u.pn = pn; return true; }
            if (nM <= 32) return false;
            const int s = ((nloc - f) * 4 + mloc) * 8 + xcd; if (s < nN) { u.pm = 32; u.pn = s; return true; } return false; }
        if (i == R && nM > 32) { const int s = 32 * (8 - f) + c; if (s < nN) { u.pm = 32; u.pn = s; return true; } }
        return false;
#else
        if (i >= imax) return false;
        const long L = (long)(i + i0) * G + c; if (L >= nwg) return false;
        int wgid = (int)L; { const int q = nwg / NXCD, r = nwg % NXCD, xcd = wgid % NXCD, off = wgid / NXCD; wgid = (xcd < r ? xcd * (q + 1) : r * (q + 1) + (xcd - r) * q) + off; }
#if PG8_MERGE_LAST
        const int nig = WGM * nN, ngrp0 = (nM + WGM - 1) / WGM, rem = nM - (ngrp0 - 1) * WGM, ngrp = (ngrp0 > 1 && rem <= WGM / 2) ? ngrp0 - 1 : ngrp0;
        const int gid0 = wgid / nig, gid = gid0 < ngrp - 1 ? gid0 : ngrp - 1, fm = gid * WGM, gsz = (gid == ngrp - 1) ? nM - fm : WGM, loc = wgid - gid * nig;
        u.pm = fm + (loc % gsz); u.pn = loc / gsz;
#else
        const int nig = WGM * nN, gid = wgid / nig, fm = gid * WGM, gsz = (nM - fm) < WGM ? (nM - fm) : WGM;
        u.pm = fm + ((wgid % nig) % gsz); u.pn = (wgid % nig) / gsz;
#endif
        u.kt0 = 0; u.nt = ntk; u.slab = -1; return true;
#endif
    }
    __device__ __forceinline__ void a_ready(const Unit&) const {}
    __device__ __forceinline__ void done(const Unit&) const {}
};

struct HotOrder : StaticOrder {
    int nrounds;
    __host__ __device__ __forceinline__ bool next(int i, Unit& u) const { if (i >= nrounds) return false; u.pm = (c >> 1) & 3; u.pn = c & 1; u.kt0 = 0; u.nt = ntk; u.slab = -1; return true; }
};

struct SplitOrder : StaticOrder {
    int nfull;
    int pmode;
    __host__ __device__ void init2(int Mfull, int N, int G_, int c_, int K_) { init(Mfull, N, G_, c_, K_); nfull = nwg / G_; pmode = -1; }
    __host__ __device__ __forceinline__ bool next(int i, Unit& u) const {
#ifndef SPLIT_REPS
#define SPLIT_REPS 1
#endif
        if (i >= (pmode < 0 ? nfull + SPLIT_REPS : (pmode == 0 ? nfull : (pmode == 1 ? 1 : nfull + 1)))) return false;
        const bool split = pmode < 0 ? (i < SPLIT_REPS) : (pmode == 1 ? true : (pmode == 2 ? (i >= nfull) : false));
        Unit f; f.pm = 0; f.pn = 0; f.kt0 = 0; f.nt = ntk; f.slab = -1;
        (void)StaticOrder::next(split ? 0 : (pmode < 0 ? i - SPLIT_REPS : i), f);
        const int pn = c & 15, s = c >> 4, npair = ntk >> 1, q = npair >> 4, r = npair & 15;
        const int k0 = 2 * (s < r ? s * (q + 1) : r * (q + 1) + (s - r) * q), ntp = 2 * (s < r ? q + 1 : q);
        u.pm = split ? nM : f.pm; u.pn = split ? pn : f.pn; u.kt0 = split ? k0 : 0; u.nt = split ? ntp : ntk; u.slab = split ? s : -1;
        return true;
    }
};

__device__ __forceinline__ unsigned cvt_pk_bf16(float lo, float hi) { unsigned r; asm volatile("v_cvt_pk_bf16_f32 %0, %1, %2" : "=v"(r) : "v"(lo), "v"(hi)); return r; }
typedef float f32x2 __attribute__((ext_vector_type(2)));
__device__ __forceinline__ float gelu_tanh(float x) {
    const float t = x * (-2.302208198f - 0.1029432397f * x * x);
    const float e = __builtin_amdgcn_exp2f(t);
    return x * __builtin_amdgcn_rcpf(1.0f + e);
}
__device__ __forceinline__ f32x4 gelu4(f32x4 v) { return (f32x4){gelu_tanh(v[0]), gelu_tanh(v[1]), gelu_tanh(v[2]), gelu_tanh(v[3])}; }
__device__ __forceinline__ u32x4 pack8(f32x4 v0, f32x4 v1) { u32x4 w; w.x = cvt_pk_bf16(v0[0], v0[1]); w.y = cvt_pk_bf16(v0[2], v0[3]); w.z = cvt_pk_bf16(v1[0], v1[1]); w.w = cvt_pk_bf16(v1[2], v1[3]); return w; }

struct EpiPlain {
    static constexpr bool PERM = true, AFTER_DRAIN = false, TWICE = false, APERM = false;
    bf16_t* O; int ldc; bf16_t* slabs;
    __device__ __forceinline__ void prefetch(const Unit&, int, int) const {}
    __device__ __forceinline__ void operator()(const f32x4 (&acc)[2][2][4][2], const Unit& u, int wr, int wc, int fr, int fq) const {
        asm volatile("" : "+v"(fr), "+v"(fq));
        const int rt0 = wr * 64 + fr, col0 = u.pn * BM + wc * 32 + 8 * fq;
        if (u.slab < 0) {
            bf16_t* ob = O + (size_t)(u.pm * BM + rt0) * ldc + col0;
#pragma unroll
            for (int ai = 0; ai < 2; ++ai)
#pragma unroll
                for (int m = 0; m < 4; ++m) {
#pragma unroll
                    for (int bj = 0; bj < 2; ++bj) *(u32x4*)(ob + (size_t)(ai * HALF + m * 16) * ldc + bj * HALF) = pack8(acc[ai][bj][m][0], acc[ai][bj][m][1]); }
        } else {
            bf16_t* sb = slabs + ((size_t)u.slab * BM + rt0) * ldc + col0;
#pragma unroll
            for (int ai = 0; ai < 2; ++ai)
#pragma unroll
                for (int m = 0; m < 4; ++m) {
#pragma unroll
                    for (int bj = 0; bj < 2; ++bj) *(u32x4*)(sb + (size_t)(ai * HALF + m * 16) * ldc + bj * HALF) = pack8(acc[ai][bj][m][0], acc[ai][bj][m][1]); }
        }
    }
};

struct EpiIn {
    static constexpr bool PERM = true, AFTER_DRAIN = false, TWICE = false, APERM = false;
    bf16_t* Z; float* ssq;
    float *out_pk, *out_pv, *out_sk, *out_sv;
    const float* rs; PG8_LAS unsigned char* aux;
    __device__ __forceinline__ void prefetch(const Unit& u, int wid, int lane) const {
        asm volatile("" : "+v"(lane));
        const float* r0 = rs + u.pm * BM + (wid >> 2) * 64 + lane;
        __builtin_amdgcn_global_load_lds((const unsigned*)r0, (PG8_LAS unsigned*)(aux + wid * 512), 4, 0, 0);
        __builtin_amdgcn_global_load_lds((const unsigned*)(r0 + HALF), (PG8_LAS unsigned*)(aux + wid * 512 + 256), 4, 0, 0);
    }
    __device__ __forceinline__ void operator()(const f32x4 (&acc)[2][2][4][2], const Unit& u, int wr, int wc, int fr, int fq) const {
        constexpr int LDZ = 6656;
        asm volatile("" : "+v"(fr), "+v"(fq));
        const int pn = u.pn;
        const bool is_q = pn < 8, is_kv = (pn == 8) || (pn == 9), is_gelu = pn >= 10, is_v = pn >= 18;
        const float scale = is_q ? 0.125f : 1.0f;
        const PG8_LAS float* rl = (const PG8_LAS float*)(aux + (wr * 4 + wc) * 512) + fr;
        const int rt0 = wr * 64 + fr, col0 = pn * BM + wc * 32 + 8 * fq, c0 = wc * 32 + 8 * fq;
        bf16_t* zb = Z + (size_t)(u.pm * BM + rt0) * LDZ + col0;
        const int pidx = (pn - 18) * 4 + wc;
        float* fo = nullptr; bool fo_hi_only = false;
        if (is_kv) { if (u.pm == 32) fo = ((pn == 8) ? out_sk : out_sv) + (size_t)rt0 * 256 + c0;
                     else if ((u.pm & 7) == 7) { fo = ((pn == 8) ? out_pk : out_pv) + ((size_t)(u.pm >> 3) * 128 + rt0 - 128) * 256 + c0; fo_hi_only = true; } }
#pragma unroll
        for (int ai = 0; ai < 2; ++ai)
#pragma unroll
            for (int m = 0; m < 4; ++m) { const int ro = ai * HALF + m * 16; float s = 0.f; const float rsc = rl[ai * 64 + m * 16] * scale;
#pragma unroll
                for (int bj = 0; bj < 2; ++bj) { f32x4 v0 = acc[ai][bj][m][0] * rsc, v1 = acc[ai][bj][m][1] * rsc;
                    if (is_gelu) { v0 = gelu4(v0); v1 = gelu4(v1); }
                    if (is_v) s += (v0[0] * v0[0] + v0[1] * v0[1]) + (v0[2] * v0[2] + v0[3] * v0[3]) + (v1[0] * v1[0] + v1[1] * v1[1]) + (v1[2] * v1[2] + v1[3] * v1[3]);
                    *(u32x4*)(zb + (size_t)ro * LDZ + bj * HALF) = pack8(v0, v1);
                    if (fo != nullptr && (!fo_hi_only || ai == 1)) { float* d = fo + (size_t)ro * 256 + bj * HALF; *(f32x4*)d = v0; *(f32x4*)(d + 4) = v1; } }
                if (is_v) { s += __shfl_xor(s, 16); s += __shfl_xor(s, 32); if (fq == 0) ssq[(size_t)(u.pm * BM + rt0 + ro) * 32 + pidx] = s; }
                asm volatile("" ::: "memory"); }
    }
};

__device__ __forceinline__ float dpp_shr1(float old, float src) { return __builtin_bit_cast(float, __builtin_amdgcn_update_dpp(__builtin_bit_cast(int, old), __builtin_bit_cast(int, src), 0x111, 0xf, 0xf, false)); }
__device__ __forceinline__ float dpp_shr2(float old, float src) { return __builtin_bit_cast(float, __builtin_amdgcn_update_dpp(__builtin_bit_cast(int, old), __builtin_bit_cast(int, src), 0x112, 0xf, 0xf, false)); }
__device__ __forceinline__ float dpp_ror1(float src) { return __builtin_bit_cast(float, __builtin_amdgcn_update_dpp(0, __builtin_bit_cast(int, src), 0x121, 0xf, 0xf, false)); }
__device__ __forceinline__ float dpp_ror2(float src) { return __builtin_bit_cast(float, __builtin_amdgcn_update_dpp(0, __builtin_bit_cast(int, src), 0x122, 0xf, 0xf, false)); }

#ifndef EPIGU_NT
#define EPIGU_NT 0
#endif
#ifndef EPIGU_TWICE
#define EPIGU_TWICE false
#endif
struct EpiGU {
    static constexpr bool PERM = true, AFTER_DRAIN = false, TWICE = EPIGU_TWICE, APERM = true;
    bf16_t* A; bf16_t* halo;
    const float *cw, *cb, *state;
    float *out_pc, *out_sc;
    PG8_LAS unsigned char* aux;
    const float* rs;
    __device__ __forceinline__ void prefetch(const Unit& u, int wid, int lane) const {
        asm volatile("" : "+v"(lane));
        const int f = u.pn * 128 + (wid & 3) * 32 + (lane & 31);
        const float* g0 = (lane < 32 ? cw : cw + 11008) + f; const float* g1 = (lane < 32 ? cw + 2 * 11008 : cb) + f;
        __builtin_amdgcn_global_load_lds((const unsigned*)g0, (PG8_LAS unsigned*)(aux + wid * 1024), 4, 0, 0);
        __builtin_amdgcn_global_load_lds((const unsigned*)g1, (PG8_LAS unsigned*)(aux + wid * 1024 + 256), 4, 0, 0);
        const float* r0 = rs + u.pm * BM + (wid >> 2) * 64 + lane;
        __builtin_amdgcn_global_load_lds((const unsigned*)r0, (PG8_LAS unsigned*)(aux + wid * 1024 + 512), 4, 0, 0);
        __builtin_amdgcn_global_load_lds((const unsigned*)(r0 + HALF), (PG8_LAS unsigned*)(aux + wid * 1024 + 768), 4, 0, 0);
    }
    template <bool SMP>
    __device__ __forceinline__ void body(const f32x4 (&acc)[2][2][4][2], const Unit& u, int wr, int wc, int fr, int fq) const {
        constexpr int FFN = 11008;
        const int f0 = u.pn * 128 + wc * 32 + 8 * fq;
        const PG8_LAS float* wl = (const PG8_LAS float*)(aux + (wr * 4 + wc) * 1024) + 8 * fq;
        const PG8_LAS float* rl = (const PG8_LAS float*)(aux + (wr * 4 + wc) * 1024 + 512) + 4 * fr;
        const int r0 = wr * 64 + 4 * fr;
        bf16_t* ab = A + (size_t)(u.pm * BM + r0) * FFN + f0;
        const bool ev = (fr & 1) == 0;
#pragma unroll
        for (int ai = 0; ai < 2; ++ai) {
            const int bs = (ai * HALF + r0) >> 3, j64 = u.pm * 4 + ai * 2 + wr;
            const f32x4 rv = *(const PG8_LAS f32x4*)(rl + ai * 64);
            unsigned lo[4][2];
#pragma unroll
            for (int n = 0; n < 2; ++n) {
                const f32x4 w0 = *(const PG8_LAS f32x4*)(wl + 4 * n), w1 = *(const PG8_LAS f32x4*)(wl + 32 + 4 * n), w2 = *(const PG8_LAS f32x4*)(wl + 64 + 4 * n), bb = *(const PG8_LAS f32x4*)(wl + 96 + 4 * n);
                f32x4 gs[4];
#pragma unroll
                for (int m = 0; m < 4; ++m) gs[m] = acc[ai][0][m][n] * rv[m];
                f32x4 d2, d3;
#pragma unroll
                for (int e = 0; e < 4; ++e) { d2[e] = dpp_shr1(0.f, gs[2][e]); d3[e] = dpp_shr1(0.f, gs[3][e]); }
                if constexpr (SMP) { if (ev) { const float* sp_ = state + (size_t)bs * 2 * FFN + f0 + 4 * n; d2 = *(const f32x4*)sp_; d3 = *(const f32x4*)(sp_ + FFN); } }
#pragma unroll
                for (int m = 0; m < 4; ++m) {
                    const f32x4 us = acc[ai][1][m][n] * rv[m];
                    const f32x4 p1 = (m == 0) ? d3 : gs[m > 0 ? m - 1 : 0];
                    const f32x4 p2 = (m == 0) ? d2 : (m == 1) ? d3 : gs[m > 1 ? m - 2 : 0];
                    const f32x4 c = w0 * p2 + w1 * p1 + w2 * gs[m] + bb;
                    const f32x4 av = gelu4(c) * us;
                    const unsigned q0 = cvt_pk_bf16(av[0], av[1]), q1 = cvt_pk_bf16(av[2], av[3]);
                    if (n == 0) { lo[m][0] = q0; lo[m][1] = q1; }
                    else if (SMP || m >= 2 || fr != 0) { u32x4 pk_; pk_.x = lo[m][0]; pk_.y = lo[m][1]; pk_.z = q0; pk_.w = q1; *(u32x4*)(ab + (size_t)(ai * HALF + m) * FFN) = pk_; }
                    if constexpr (SMP) {
                        if (m >= 2 && !ev) *(f32x4*)(out_sc + ((size_t)bs * 2 + (m - 2)) * FFN + f0 + 4 * n) = gs[m];
                    } else {
                        if (m < 2 && fr == 0) { bf16_t* hg = halo + ((size_t)j64 * 6 + m) * FFN + f0 + 4 * n; *(uint2*)hg = make_uint2(cvt_pk_bf16(gs[m][0], gs[m][1]), cvt_pk_bf16(gs[m][2], gs[m][3])); *(uint2*)(hg + 2 * FFN) = make_uint2(cvt_pk_bf16(us[0], us[1]), cvt_pk_bf16(us[2], us[3])); }
                        if (m >= 2 && fr == 15) { bf16_t* hg = halo + ((size_t)j64 * 6 + 4 + (m - 2)) * FFN + f0 + 4 * n; *(uint2*)hg = make_uint2(cvt_pk_bf16(gs[m][0], gs[m][1]), cvt_pk_bf16(gs[m][2], gs[m][3]));
                            if ((u.pm & 7) == 7 && ai == 1 && wr == 1) *(f32x4*)(out_pc + ((size_t)(u.pm >> 3) * 2 + (m - 2)) * FFN + f0 + 4 * n) = gs[m]; }
                    }
                }
                asm volatile("" ::: "memory");
            }
        }
    }
    __device__ __forceinline__ void operator()(const f32x4 (&acc)[2][2][4][2], const Unit& u, int wr, int wc, int fr, int fq) const {
        asm volatile("" : "+v"(fr), "+v"(fq));
        if (u.pm == 32) body<true>(acc, u, wr, wc, fr, fq); else body<false>(acc, u, wr, wc, fr, fq);
    }
};

template <class Epi, class Sched, bool ALIGN_EPI = false, bool SP2 = false>
__device__ __forceinline__ void gemm_phase(PG8_LAS unsigned char* lds, const Gemm g, const Sched& S, const Epi& E, int wave_in) {
    int wv_l = wave_in; asm volatile("" : "+s"(wv_l)); int ln_l; asm volatile("v_mbcnt_lo_u32_b32 %0, -1, 0\n\tv_mbcnt_hi_u32_b32 %0, -1, %0" : "=v"(ln_l)); const int tid_l = wv_l * 64 + ln_l;
    const int tid = tid_l, wid = __builtin_amdgcn_readfirstlane(tid >> 6), lane = tid & 63, wr = wid >> 2, wc = wid & 3, fr = lane & 15, fq = lane >> 4;
    const int K = g.K;
    unsigned voffA[2], voffB[2];
#pragma unroll
    for (int i = 0; i < 2; ++i) { int R, C; stage_rc(tid * 16 + i * 8192, R, C); const int Rb = Epi::PERM ? ((R & ~31) + perm32(R & 31)) : R;
        const int Ra = Epi::APERM ? ((R & 64) + 4 * (R & 15) + ((R >> 4) & 3)) : R;
        voffA[i] = (unsigned)(Ra * K + C) * 2u; voffB[i] = (unsigned)(Rb * K + C) * 2u; }
    const size_t kstep = (size_t)(BK * 2);
    const size_t hstep = (size_t)HALF * K * 2;
    const size_t tstep = 2 * hstep;
    const unsigned ldsw = (unsigned)wid * 1024u;
    const int aoff = lds_byte(wr * 64 + fr, fq * 8), boff = lds_byte(wc * 32 + fr, fq * 8);
#define PG8_SA(b, h) (((b) * 2 + (h)) * HTB)
#define PG8_SB(b, h) ((4 + (b) * 2 + (h)) * HTB)
#define PG8_STAGE(bufoff, gbase, voff) do { _Pragma("unroll") for (int _i = 0; _i < 2; ++_i) \
        __builtin_amdgcn_global_load_lds((const unsigned*)((const char*)(gbase) + (voff)[_i]), (PG8_LAS unsigned*)(lds + (bufoff) + ldsw + _i * 8192), 16, 0, 0); } while (0)
#ifndef PG8_B_AUX
#define PG8_B_AUX 0
#endif
#define PG8_STAGEB(bufoff, gbase, voff) do { _Pragma("unroll") for (int _i = 0; _i < 2; ++_i) \
        __builtin_amdgcn_global_load_lds((const unsigned*)((const char*)(gbase) + (voff)[_i]), (PG8_LAS unsigned*)(lds + (bufoff) + ldsw + _i * 8192), 16, 0, PG8_B_AUX); } while (0)
#define PG8_LDA(dst, b, h) do { _Pragma("unroll") for (int m = 0; m < 4; ++m) _Pragma("unroll") for (int k = 0; k < 2; ++k) dst[m][k] = *(const PG8_LAS bf16x8*)(lds + PG8_SA(b, h) + aoff + m * 2048 + k * 1024); } while (0)
#define PG8_LDB(dst, b, h) do { _Pragma("unroll") for (int n = 0; n < 2; ++n) _Pragma("unroll") for (int k = 0; k < 2; ++k) dst[n][k] = *(const PG8_LAS bf16x8*)(lds + PG8_SB(b, h) + boff + n * 2048 + k * 1024); } while (0)
#ifndef PG8_PRIO
#define PG8_PRIO 1
#endif
#define PG8_MMA(ai, bj, At, Bt) do { if (PG8_PRIO) __builtin_amdgcn_s_setprio(PG8_PRIO); _Pragma("unroll") for (int m = 0; m < 4; ++m) _Pragma("unroll") for (int n = 0; n < 2; ++n) _Pragma("unroll") for (int k = 0; k < 2; ++k) \
        acc[ai][bj][m][n] = __builtin_amdgcn_mfma_f32_16x16x32_bf16(Bt[n][k], At[m][k], acc[ai][bj][m][n], 0, 0, 0); if (PG8_PRIO) __builtin_amdgcn_s_setprio(0); } while (0)
#ifndef PG8_PRIO_MODE
#define PG8_PRIO_MODE 1
#endif
#ifndef PG8_MMA_ORDER
#define PG8_MMA_ORDER 0
#endif
#if PG8_MMA_ORDER == 1
#define PG8_MMA_NP(ai, bj, At, Bt) do { _Pragma("unroll") for (int k = 0; k < 2; ++k) _Pragma("unroll") for (int n = 0; n < 2; ++n) _Pragma("unroll") for (int m = 0; m < 4; ++m) \
        acc[ai][bj][m][n] = __builtin_amdgcn_mfma_f32_16x16x32_bf16(Bt[n][k], At[m][k], acc[ai][bj][m][n], 0, 0, 0); } while (0)
#elif PG8_MMA_ORDER == 2
#define PG8_MMA_NP(ai, bj, At, Bt) do { _Pragma("unroll") for (int k = 0; k < 2; ++k) _Pragma("unroll") for (int m = 0; m < 4; ++m) _Pragma("unroll") for (int n = 0; n < 2; ++n) \
        acc[ai][bj][m][n] = __builtin_amdgcn_mfma_f32_16x16x32_bf16(Bt[n][k], At[m][k], acc[ai][bj][m][n], 0, 0, 0); } while (0)
#else
#define PG8_MMA_NP(ai, bj, At, Bt) do { _Pragma("unroll") for (int m = 0; m < 4; ++m) _Pragma("unroll") for (int n = 0; n < 2; ++n) _Pragma("unroll") for (int k = 0; k < 2; ++k) \
        acc[ai][bj][m][n] = __builtin_amdgcn_mfma_f32_16x16x32_bf16(Bt[n][k], At[m][k], acc[ai][bj][m][n], 0, 0, 0); } while (0)
#endif
#if PG8_MMA_ORDER == 3
#define PG8_MMA2(ai, At, B0, B1) do { _Pragma("unroll") for (int k = 0; k < 2; ++k) _Pragma("unroll") for (int m = 0; m < 4; ++m) _Pragma("unroll") for (int n = 0; n < 2; ++n) { \
        acc[ai][0][m][n] = __builtin_amdgcn_mfma_f32_16x16x32_bf16(B0[n][k], At[m][k], acc[ai][0][m][n], 0, 0, 0); acc[ai][1][m][n] = __builtin_amdgcn_mfma_f32_16x16x32_bf16(B1[n][k], At[m][k], acc[ai][1][m][n], 0, 0, 0); } } while (0)
#elif PG8_MMA_ORDER == 4
#define PG8_MMA2(ai, At, B0, B1) do { _Pragma("unroll") for (int k = 0; k < 2; ++k) _Pragma("unroll") for (int n = 0; n < 2; ++n) { _Pragma("unroll") for (int m = 0; m < 4; ++m) \
        acc[ai][0][m][n] = __builtin_amdgcn_mfma_f32_16x16x32_bf16(B0[n][k], At[m][k], acc[ai][0][m][n], 0, 0, 0); _Pragma("unroll") for (int m = 0; m < 4; ++m) acc[ai][1][m][n] = __builtin_amdgcn_mfma_f32_16x16x32_bf16(B1[n][k], At[m][k], acc[ai][1][m][n], 0, 0, 0); } } while (0)
#elif PG8_MMA_ORDER == 6
#define PG8_MMA2_ONE(ai, At, B0, B1, k, j, m) do { if (((j) & 1) == 0) acc[ai][0][m][(j) >> 1] = __builtin_amdgcn_mfma_f32_16x16x32_bf16(B0[(j) >> 1][k], At[m][k], acc[ai][0][m][(j) >> 1], 0, 0, 0); \
        else acc[ai][1][m][(j) >> 1] = __builtin_amdgcn_mfma_f32_16x16x32_bf16(B1[(j) >> 1][k], At[m][k], acc[ai][1][m][(j) >> 1], 0, 0, 0); } while (0)
#define PG8_MMA2(ai, At, B0, B1) do { _Pragma("unroll") for (int k = 0; k < 2; ++k) _Pragma("unroll") for (int s = 0; s < 4; ++s) _Pragma("unroll") for (int j = 0; j < 4; ++j) PG8_MMA2_ONE(ai, At, B0, B1, k, j, ((j + s) & 3)); } while (0)
#elif PG8_MMA_ORDER == 7
#define PG8_MMA2_ONE(ai, At, B0, B1, k, j, m) do { if (((j) & 1) == 0) acc[ai][0][m][(j) >> 1] = __builtin_amdgcn_mfma_f32_16x16x32_bf16(B0[(j) >> 1][k], At[m][k], acc[ai][0][m][(j) >> 1], 0, 0, 0); \
        else acc[ai][1][m][(j) >> 1] = __builtin_amdgcn_mfma_f32_16x16x32_bf16(B1[(j) >> 1][k], At[m][k], acc[ai][1][m][(j) >> 1], 0, 0, 0); } while (0)
#define PG8_MMA2(ai, At, B0, B1) do { _Pragma("unroll") for (int k = 0; k < 2; ++k) _Pragma("unroll") for (int mp = 0; mp < 2; ++mp) _Pragma("unroll") for (int j = 0; j < 4; ++j) _Pragma("unroll") for (int mi = 0; mi < 2; ++mi) PG8_MMA2_ONE(ai, At, B0, B1, k, j, (2 * mp + mi)); } while (0)
#elif PG8_MMA_ORDER == 8
#define PG8_MMA2_ONE(ai, At, B0, B1, k, j, m) do { if (((j) & 1) == 0) acc[ai][0][m][(j) >> 1] = __builtin_amdgcn_mfma_f32_16x16x32_bf16(B0[(j) >> 1][k], At[m][k], acc[ai][0][m][(j) >> 1], 0, 0, 0); \
        else acc[ai][1][m][(j) >> 1] = __builtin_amdgcn_mfma_f32_16x16x32_bf16(B1[(j) >> 1][k], At[m][k], acc[ai][1][m][(j) >> 1], 0, 0, 0); } while (0)
#define PG8_MMA2(ai, At, B0, B1) do { _Pragma("unroll") for (int k = 0; k < 2; ++k) { PG8_MMA2_ONE(ai, At, B0, B1, k, 0, 0); PG8_MMA2_ONE(ai, At, B0, B1, k, 1, 0); PG8_MMA2_ONE(ai, At, B0, B1, k, 1, 1); PG8_MMA2_ONE(ai, At, B0, B1, k, 0, 1); PG8_MMA2_ONE(ai, At, B0, B1, k, 0, 2); PG8_MMA2_ONE(ai, At, B0, B1, k, 1, 2); PG8_MMA2_ONE(ai, At, B0, B1, k, 1, 3); PG8_MMA2_ONE(ai, At, B0, B1, k, 0, 3); PG8_MMA2_ONE(ai, At, B0, B1, k, 2, 3); PG8_MMA2_ONE(ai, At, B0, B1, k, 3, 3); PG8_MMA2_ONE(ai, At, B0, B1, k, 3, 2); PG8_MMA2_ONE(ai, At, B0, B1, k, 2, 2); PG8_MMA2_ONE(ai, At, B0, B1, k, 2, 1); PG8_MMA2_ONE(ai, At, B0, B1, k, 3, 1); PG8_MMA2_ONE(ai, At, B0, B1, k, 3, 0); PG8_MMA2_ONE(ai, At, B0, B1, k, 2, 0); } } while (0)
#elif PG8_MMA_ORDER == 5
#define PG8_MMA2(ai, At, B0, B1) do { _Pragma("unroll") for (int m = 0; m < 4; ++m) _Pragma("unroll") for (int k = 0; k < 2; ++k) _Pragma("unroll") for (int n = 0; n < 2; ++n) { \
        acc[ai][0][m][n] = __builtin_amdgcn_mfma_f32_16x16x32_bf16(B0[n][k], At[m][k], acc[ai][0][m][n], 0, 0, 0); acc[ai][1][m][n] = __builtin_amdgcn_mfma_f32_16x16x32_bf16(B1[n][k], At[m][k], acc[ai][1][m][n], 0, 0, 0); } } while (0)
#else
#define PG8_MMA2(ai, At, B0, B1) do { PG8_MMAX(ai, 0, At, B0); PG8_MMAX(ai, 1, At, B1); } while (0)
#endif
#ifndef PG8_EARLYBAR
#define PG8_EARLYBAR 0
#endif
#define PG8_MMA_M(ai, bj, At, Bt, M0, M1) do { _Pragma("unroll") for (int m = (M0); m < (M1); ++m) _Pragma("unroll") for (int n = 0; n < 2; ++n) _Pragma("unroll") for (int k = 0; k < 2; ++k) \
        acc[ai][bj][m][n] = __builtin_amdgcn_mfma_f32_16x16x32_bf16(Bt[n][k], At[m][k], acc[ai][bj][m][n], 0, 0, 0); } while (0)
#if PG8_PRIO_MODE == 0
#define PG8_MMAX(ai, bj, At, Bt) PG8_MMA(ai, bj, At, Bt)
#define PG8_PRI_PRE
#define PG8_PRI_ON
#define PG8_PRI_OFF
#define PG8_PRI_POST
#elif PG8_PRIO_MODE == 1
#define PG8_MMAX(ai, bj, At, Bt) PG8_MMA_NP(ai, bj, At, Bt)
#define PG8_PRI_PRE
#define PG8_PRI_ON __builtin_amdgcn_s_setprio(1)
#define PG8_PRI_OFF __builtin_amdgcn_s_setprio(0)
#define PG8_PRI_POST
#else
#define PG8_MMAX(ai, bj, At, Bt) PG8_MMA_NP(ai, bj, At, Bt)
#define PG8_PRI_PRE __builtin_amdgcn_s_setprio(1)
#define PG8_PRI_ON
#define PG8_PRI_OFF
#define PG8_PRI_POST __builtin_amdgcn_s_setprio(0)
#endif
#define PG8_WAIT_V(n) asm volatile("s_waitcnt vmcnt(" #n ")" ::: "memory")
#define PG8_WAIT_L(n) asm volatile("s_waitcnt lgkmcnt(" #n ")" ::: "memory")
#define PG8_BAR __builtin_amdgcn_s_barrier()
#define PG8_SCHED __builtin_amdgcn_sched_barrier(0)
    Unit cur, nxt; int ui = 0;
    if (!S.next(0, cur)) return;
    f32x4 acc[2][2][4][2];
#pragma unroll
    for (int a = 0; a < 2; ++a)
#pragma unroll
        for (int b = 0; b < 2; ++b)
#pragma unroll
            for (int m = 0; m < 4; ++m)
#pragma unroll
                for (int n = 0; n < 2; ++n) acc[a][b][m][n] = (f32x4){0.f, 0.f, 0.f, 0.f};
    bf16x8 At[4][2], B0[2][2], B1[2][2];
    const char* cA = (const char*)g.A + (size_t)cur.pm * tstep + (size_t)cur.kt0 * kstep; const char* cB = (const char*)g.Bt + (size_t)cur.pn * tstep + (size_t)cur.kt0 * kstep;
    S.a_ready(cur);
    if constexpr (SP2) {
        PG8_STAGEB(PG8_SB(0, 0), cB, voffB); PG8_STAGEB(PG8_SB(0, 1), cB + hstep, voffB); PG8_STAGE(PG8_SA(0, 0), cA, voffA); PG8_STAGE(PG8_SA(0, 1), cA + hstep, voffA);
        if (wr == 1) PG8_BAR;
        PG8_WAIT_V(2); PG8_BAR;
        PG8_STAGEB(PG8_SB(1, 0), cB + kstep, voffB); PG8_STAGE(PG8_SA(1, 0), cA + kstep, voffA); PG8_STAGEB(PG8_SB(1, 1), cB + hstep + kstep, voffB);
        PG8_WAIT_V(6); PG8_BAR;
    } else {
        PG8_STAGEB(PG8_SB(0, 0), cB, voffB); PG8_STAGE(PG8_SA(0, 0), cA, voffA); PG8_STAGEB(PG8_SB(0, 1), cB + hstep, voffB); PG8_STAGE(PG8_SA(0, 1), cA + hstep, voffA);
        if (wr == 1) PG8_BAR;
        PG8_WAIT_V(4); PG8_BAR;
        PG8_STAGEB(PG8_SB(1, 0), cB + kstep, voffB); PG8_STAGE(PG8_SA(1, 0), cA + kstep, voffA); PG8_STAGEB(PG8_SB(1, 1), cB + hstep + kstep, voffB);
        PG8_WAIT_V(6); PG8_BAR;
    }
    for (;;) {
        const bool has_next = S.next(ui + 1, nxt);
        const char* nA = has_next ? (const char*)g.A + (size_t)nxt.pm * tstep + (size_t)nxt.kt0 * kstep : cA; const char* nB = has_next ? (const char*)g.Bt + (size_t)nxt.pn * tstep + (size_t)nxt.kt0 * kstep : cB;
        const int nt = cur.nt;
        E.prefetch(cur, wid, lane);
        for (int t = 0; t < nt; t += 2) {
            const bool last = (t == nt - 2);
            const char* a1 = cA + (size_t)(t + 1) * kstep;
            const char* a2 = last ? nA : cA + (size_t)(t + 2) * kstep; const char* b2 = last ? nB : cB + (size_t)(t + 2) * kstep;
            const char* a3 = a2 + kstep; const char* b3 = b2 + kstep;
            if (last && has_next) S.a_ready(nxt);
            if constexpr (SP2) {
            PG8_LDB(B0, 0, 0); PG8_LDB(B1, 0, 1); PG8_SCHED; PG8_LDA(At, 0, 0); PG8_STAGE(PG8_SA(1, 1), a1 + hstep, voffA);
            PG8_WAIT_V(8); PG8_WAIT_L(0); PG8_BAR; if constexpr (PG8_EARLYBAR != 0) { __builtin_amdgcn_s_setprio(1); PG8_MMA_M(0, 0, At, B0, 0, 4); PG8_MMA_M(0, 1, At, B1, 0, 4 - PG8_EARLYBAR); __builtin_amdgcn_s_setprio(0); PG8_SCHED; PG8_BAR; PG8_SCHED; __builtin_amdgcn_s_setprio(1); PG8_MMA_M(0, 1, At, B1, 4 - PG8_EARLYBAR, 4); __builtin_amdgcn_s_setprio(0); } else { PG8_PRI_ON; PG8_MMA2(0, At, B0, B1); PG8_PRI_OFF; PG8_BAR; } PG8_SCHED;
            PG8_LDA(At, 0, 1); PG8_STAGEB(PG8_SB(0, 0), b2, voffB); PG8_STAGEB(PG8_SB(0, 1), b2 + hstep, voffB); PG8_STAGE(PG8_SA(0, 0), a2, voffA);
            PG8_WAIT_V(8); PG8_WAIT_L(0); PG8_BAR; if constexpr (PG8_EARLYBAR != 0) { __builtin_amdgcn_s_setprio(1); PG8_MMA_M(1, 0, At, B0, 0, 4); PG8_MMA_M(1, 1, At, B1, 0, 4 - PG8_EARLYBAR); __builtin_amdgcn_s_setprio(0); PG8_SCHED; PG8_BAR; PG8_SCHED; __builtin_amdgcn_s_setprio(1); PG8_MMA_M(1, 1, At, B1, 4 - PG8_EARLYBAR, 4); __builtin_amdgcn_s_setprio(0); } else { PG8_PRI_ON; PG8_MMA2(1, At, B0, B1); PG8_PRI_OFF; PG8_BAR; } PG8_SCHED;
            PG8_LDB(B0, 1, 0); PG8_LDB(B1, 1, 1); PG8_SCHED; PG8_LDA(At, 1, 0); PG8_STAGE(PG8_SA(0, 1), a2 + hstep, voffA);
            PG8_WAIT_V(8); PG8_WAIT_L(0); PG8_BAR; if constexpr (PG8_EARLYBAR != 0) { __builtin_amdgcn_s_setprio(1); PG8_MMA_M(0, 0, At, B0, 0, 4); PG8_MMA_M(0, 1, At, B1, 0, 4 - PG8_EARLYBAR); __builtin_amdgcn_s_setprio(0); PG8_SCHED; PG8_BAR; PG8_SCHED; __builtin_amdgcn_s_setprio(1); PG8_MMA_M(0, 1, At, B1, 4 - PG8_EARLYBAR, 4); __builtin_amdgcn_s_setprio(0); } else { PG8_PRI_ON; PG8_MMA2(0, At, B0, B1); PG8_PRI_OFF; PG8_BAR; } PG8_SCHED;
            PG8_LDA(At, 1, 1); PG8_STAGEB(PG8_SB(1, 0), b3, voffB); PG8_STAGEB(PG8_SB(1, 1), b3 + hstep, voffB); PG8_STAGE(PG8_SA(1, 0), a3, voffA);
            PG8_WAIT_V(8); PG8_WAIT_L(0); PG8_BAR; if constexpr (PG8_EARLYBAR != 0) { __builtin_amdgcn_s_setprio(1); PG8_MMA_M(1, 0, At, B0, 0, 4); PG8_MMA_M(1, 1, At, B1, 0, 4 - PG8_EARLYBAR); __builtin_amdgcn_s_setprio(0); PG8_SCHED; PG8_BAR; PG8_SCHED; __builtin_amdgcn_s_setprio(1); PG8_MMA_M(1, 1, At, B1, 4 - PG8_EARLYBAR, 4); __builtin_amdgcn_s_setprio(0); } else { PG8_PRI_ON; PG8_MMA2(1, At, B0, B1); PG8_PRI_OFF; PG8_BAR; } PG8_SCHED;
            } else {
            PG8_LDB(B0, 0, 0); PG8_SCHED; PG8_LDA(At, 0, 0); PG8_STAGE(PG8_SA(1, 1), a1 + hstep, voffA);
            PG8_WAIT_L(8); PG8_BAR; PG8_WAIT_L(0); PG8_MMA(0, 0, At, B0); PG8_BAR; PG8_SCHED;
            PG8_LDB(B1, 0, 1); PG8_STAGEB(PG8_SB(0, 0), b2, voffB);
            PG8_BAR; PG8_WAIT_L(0); PG8_MMA(0, 1, At, B1); PG8_BAR;
            PG8_LDA(At, 0, 1); PG8_STAGE(PG8_SA(0, 0), a2, voffA);
            PG8_BAR; PG8_WAIT_L(0); PG8_MMA(1, 0, At, B0); PG8_BAR; PG8_SCHED;
            PG8_STAGEB(PG8_SB(0, 1), b2 + hstep, voffB);
            PG8_WAIT_V(6); PG8_BAR; PG8_MMA(1, 1, At, B1); PG8_BAR;
            PG8_LDB(B0, 1, 0); PG8_SCHED; PG8_LDA(At, 1, 0); PG8_STAGE(PG8_SA(0, 1), a2 + hstep, voffA);
            PG8_WAIT_L(8); PG8_BAR; PG8_WAIT_L(0); PG8_MMA(0, 0, At, B0); PG8_BAR; PG8_SCHED;
            PG8_LDB(B1, 1, 1); PG8_STAGEB(PG8_SB(1, 0), b3, voffB);
            PG8_BAR; PG8_WAIT_L(0); PG8_MMA(0, 1, At, B1); PG8_BAR;
            PG8_LDA(At, 1, 1); PG8_STAGE(PG8_SA(1, 0), a3, voffA);
            PG8_BAR; PG8_WAIT_L(0); PG8_MMA(1, 0, At, B0); PG8_BAR; PG8_SCHED;
            PG8_STAGEB(PG8_SB(1, 1), b3 + hstep, voffB);
            PG8_WAIT_V(6); PG8_BAR; PG8_MMA(1, 1, At, B1); PG8_BAR;
            }
        }
        if constexpr (ALIGN_EPI) { if (wr == 0) PG8_BAR; }
        if constexpr (!Epi::AFTER_DRAIN) { E(acc, cur, wr, wc, fr, fq); if constexpr (Epi::TWICE) { asm volatile("" ::: "memory"); E(acc, cur, wr, wc, fr, fq); } S.done(cur); }
        if (!has_next) break;
#pragma unroll
        for (int a = 0; a < 2; ++a)
#pragma unroll
            for (int b = 0; b < 2; ++b)
#pragma unroll
                for (int m = 0; m < 4; ++m)
#pragma unroll
                    for (int n = 0; n < 2; ++n) acc[a][b][m][n] = (f32x4){0.f, 0.f, 0.f, 0.f};
        cur = nxt; cA = nA; cB = nB; ++ui;
        if constexpr (ALIGN_EPI) { if (wr == 1) PG8_BAR; }
    }
    PG8_WAIT_V(0);
    if constexpr (!ALIGN_EPI) { if (wr == 0) PG8_BAR; }
    PG8_BAR;
    if constexpr (Epi::AFTER_DRAIN) { E.fused(acc, cur, wr, wc, fr, fq, lds, wid, lane); S.done(cur); }
#undef PG8_SA
#undef PG8_SB
#undef PG8_STAGE
#undef PG8_STAGEB
#undef PG8_LDA
#undef PG8_LDB
#undef PG8_MMA
#undef PG8_MMA_NP
#undef PG8_MMA_M
#undef PG8_MMAX
#undef PG8_MMA2
#undef PG8_PRI_PRE
#undef PG8_PRI_ON
#undef PG8_PRI_OFF
#undef PG8_PRI_POST
#undef PG8_WAIT_V
#undef PG8_WAIT_L
#undef PG8_BAR
#undef PG8_SCHED
}
}
#ifndef PROBE_SKEW_MULT
#define PROBE_SKEW_MULT 10
#endif
#ifndef PROBE_SKEW_MODE
#define PROBE_SKEW_MODE 0
#endif
#ifndef PROBE_SKEW_REM
#define PROBE_SKEW_REM 0
#endif
#ifndef SKIP_MASK
#define SKIP_MASK 0
#endif
#define SK(b) (((SKIP_MASK) >> (b)) & 1)
#ifndef REPEAT_MASK
#define REPEAT_MASK 0
#endif
#define RP(b) (((REPEAT_MASK) >> (b)) & 1)
#ifndef PG8_SP2
#define PG8_SP2 true
#endif
#ifndef PG8_ALIGN
#define PG8_ALIGN true
#endif
constexpr int NWAVES = 8;
constexpr int DM = 4096, NPR = 8192, NSM = 256, MT = NPR + NSM, SEQL = 2048, NBATCH = 4, DBATCH = 32, DSEQ = 8;
constexpr int QCOLS = 2048, KVCOLS = 256, GMW = 2048, INC = 6656, FFN = 11008, NGU = 2 * FFN;
constexpr int COL_K = 2048, COL_V = 2304, COL_U = 2560, COL_GV = 4608;
constexpr int NLAYER = 2;
constexpr float EPS = 1e-6f;
constexpr float LOG2E = 1.4426950408889634f;
constexpr size_t O_YP = 0, O_YS = 33554432, O_PK = 34603008, O_PV = 34865152, O_PC = 35127296, O_SK = 35303424, O_SV = 35434496, O_SC = 35565568, O_SG = 36974592, O_END = 38023168;
constexpr size_t MiB = 1u << 20;
constexpr size_t WS_CTL = 0, CTL_ZERO_BYTES = 64 * 1024;
constexpr size_t WL_IN = 0, WL_OUT = 52 * MiB, WL_GU = 84 * MiB, WL_DN = 256 * MiB, WL_STRIDE = 342 * MiB;
constexpr size_t WS_W = 1 * MiB;
constexpr size_t WS_TRIL = WS_W + 2 * WL_STRIDE;
constexpr size_t WS_H = WS_TRIL + 1 * MiB;
constexpr size_t WS_R1 = WS_H + 66 * MiB;
constexpr size_t WS_Z = WS_R1, WS_MIX = WS_R1 + 108 * MiB, WS_A = WS_R1;
constexpr size_t WS_MF = WS_R1 + 178 * MiB;
constexpr size_t WS_SSQ = WS_MF + 66 * MiB;
constexpr size_t WS_HALO = WS_SSQ + 2 * MiB;
constexpr size_t WS_SLAB = WS_HALO + 33 * MiB;
constexpr size_t WS_XB = WS_SLAB + 64 * MiB;
constexpr size_t WS_RS = WS_XB + 66 * MiB;
constexpr size_t WS_END = WS_RS + 1 * MiB;
static_assert((size_t)INC * DM * 2 <= 52 * MiB && (size_t)DM * DM * 2 <= 32 * MiB && (size_t)NGU * DM * 2 <= 172 * MiB && (size_t)DM * FFN * 2 <= 86 * MiB, "weight map");
static_assert((size_t)MT * INC * 2 <= 108 * MiB && (size_t)MT * DM * 2 <= 66 * MiB && (size_t)MT * FFN * 2 <= 178 * MiB && (size_t)128 * 6 * FFN * 4 <= 33 * MiB, "activation map");
constexpr int CW_BAR = 4096;
constexpr int RING_OFF = 0, RING_BYTES = 131072;
constexpr int LDSCTL_OFF = RING_BYTES, MISC_OFF = LDSCTL_OFF + 320;
constexpr int LDS_BYTES = 147456;
#define GAS __attribute__((address_space(1)))
#define LAS __attribute__((address_space(3)))
typedef unsigned short bf16;
typedef unsigned v4u __attribute__((ext_vector_type(4)));
typedef float f32x4 __attribute__((ext_vector_type(4)));
typedef short bf16x8 __attribute__((ext_vector_type(8)));
typedef GAS unsigned gu32;
typedef GAS unsigned long long gu64;
#define RLX_AGENT __ATOMIC_RELAXED, __HIP_MEMORY_SCOPE_AGENT
#define LDS_WAIT() asm volatile("s_waitcnt lgkmcnt(0)" ::: "memory")
#define VM_WAIT() asm volatile("s_waitcnt vmcnt(0)" ::: "memory")
__device__ __forceinline__ unsigned long long rt() { return __builtin_amdgcn_s_memrealtime(); }
__device__ __forceinline__ unsigned f2bf(float f) { unsigned u = __builtin_bit_cast(unsigned, f); return (u + 0x7fffu + ((u >> 16) & 1u)) >> 16; }
__device__ __forceinline__ unsigned pk2(float lo, float hi) { return f2bf(lo) | (f2bf(hi) << 16); }

#define XB_TMO      128
#define XB_XCNT(j)  (256  + 64 * (j))
#define XB_XSUB(j)  (1280 + 64 * (j))
#define XB_XGEN(j)  (2304 + 64 * (j))
#define XB_TOP      3328
#define XB_TOPGEN   3392
#define XCD_BAR_WORDS 3456
#define XB_SPIN_CAP (1u << 18)

__device__ __forceinline__ unsigned xb_ld(unsigned* p)              { return __hip_atomic_load(p, __ATOMIC_RELAXED, __HIP_MEMORY_SCOPE_AGENT); }
__device__ __forceinline__ unsigned xb_add(unsigned* p, unsigned v) { return __hip_atomic_fetch_add(p, v, __ATOMIC_RELAXED, __HIP_MEMORY_SCOPE_AGENT); }
__device__ __forceinline__ unsigned xb_xcc_id() { return (unsigned)__builtin_amdgcn_s_getreg((3 << 11) | 20) & 0xFu; }
#define XB_SPIN(cond, bar) do { unsigned _sp = 0; while (cond) { __builtin_amdgcn_s_sleep(1); \
    if ((++_sp & 255u) == 0u) { if (xb_ld(&(bar)[XB_TMO])) break; if (_sp > XB_SPIN_CAP) { atomicAdd(&(bar)[XB_TMO], 1u); break; } } } } while (0)

struct XcdBarrier {
    unsigned* bar; unsigned x;
    volatile LAS unsigned* st;
};

__device__ __forceinline__ XcdBarrier xcd_barrier_post(unsigned* bar, volatile LAS unsigned* st) {
    XcdBarrier b; b.bar = bar; b.x = xb_xcc_id(); b.st = st;
    if (threadIdx.x == 0) (void)xb_add(&bar[XB_XCNT(b.x)], 1u);
    return b;
}
__device__ __forceinline__ void xcd_barrier_complete(unsigned* bar, unsigned x, unsigned& nloc, unsigned& nx) {
    const unsigned G = gridDim.x * gridDim.y * gridDim.z;
    unsigned sum, cnt, mine, sp = 0u;
    for (;;) {
        sum = 0u; cnt = 0u; mine = 0u;
#pragma unroll
        for (unsigned j = 0; j < 16; ++j) { const unsigned c = xb_ld(&bar[XB_XCNT(j)]); sum += c; cnt += (c > 0u) ? 1u : 0u; mine = (j == x) ? c : mine; }
        if (sum == G) break;
        __builtin_amdgcn_s_sleep(1);
        if ((++sp & 255u) == 0u) { if (xb_ld(&bar[XB_TMO])) break; if (sp > XB_SPIN_CAP) { atomicAdd(&bar[XB_TMO], 1u); break; } }
    }
    nloc = mine > 0u ? mine : 1u; nx = cnt > 0u ? cnt : 1u;
}

__device__ __forceinline__ void xcd_barrier(const XcdBarrier& b) {
    asm volatile("s_waitcnt vmcnt(0)" ::: "memory");
    __syncthreads();
    if (threadIdx.x == 0) {
        unsigned* bar = b.bar;
        __builtin_amdgcn_s_waitcnt(0);
        unsigned bx_ = b.x; asm volatile("" : "+s"(bx_));
        unsigned nloc = b.st[0], nx = b.st[1];
        if (nloc == 0u) { xcd_barrier_complete(bar, bx_, nloc, nx); b.st[0] = nloc; b.st[1] = nx; }
        const unsigned old = xb_add(&bar[XB_XSUB(bx_)], 1u);
        const unsigned gen = old / nloc;
        if (old + 1u == (gen + 1u) * nloc) {
            __builtin_amdgcn_fence(__ATOMIC_RELEASE, "agent");
            asm volatile("s_waitcnt vmcnt(0)" ::: "memory");
            const unsigned og = xb_add(&bar[XB_TOP], 1u);
            const unsigned tg = og / nx;
            if (og + 1u == (tg + 1u) * nx) xb_add(&bar[XB_TOPGEN], 1u);
            else XB_SPIN(xb_ld(&bar[XB_TOPGEN]) == tg, bar);
            __builtin_amdgcn_fence(__ATOMIC_ACQUIRE, "agent");
            xb_add(&bar[XB_XGEN(bx_)], 1u);
            asm volatile("s_waitcnt vmcnt(0)" ::: "memory");
        } else {
            XB_SPIN(xb_ld(&bar[XB_XGEN(bx_)]) == gen, bar);
            __builtin_amdgcn_fence(__ATOMIC_ACQUIRE, "agent");
            asm volatile("s_waitcnt vmcnt(0)" ::: "memory");
        }
    }
    __syncthreads();
}
typedef float f32x16 __attribute__((ext_vector_type(16)));
typedef unsigned v2u __attribute__((ext_vector_type(2)));
__device__ __forceinline__ unsigned cvtpk(float lo, float hi) { return pg8::cvt_pk_bf16(lo, hi); }
__device__ __forceinline__ float bflo(unsigned w) { return __uint_as_float(w << 16); }
__device__ __forceinline__ float bfhi(unsigned w) { return __uint_as_float(w & 0xffff0000u); }
__device__ __forceinline__ float wave_sum(float v) {
#define WSUM_STEP(o) v += __builtin_bit_cast(float, __builtin_amdgcn_ds_swizzle(__builtin_bit_cast(int, v), ((o) << 10) | 0x1f))
    WSUM_STEP(1); WSUM_STEP(2); WSUM_STEP(4); WSUM_STEP(8); WSUM_STEP(16);
#undef WSUM_STEP
    return __builtin_bit_cast(float, __builtin_amdgcn_readlane(__builtin_bit_cast(int, v), 0)) + __builtin_bit_cast(float, __builtin_amdgcn_readlane(__builtin_bit_cast(int, v), 32));
}
__device__ __forceinline__ int crow(int r, int hi) { return (r & 3) + 8 * (r >> 2) + 4 * hi; }

constexpr int I_IN = (DM / 64) * (INC / 64), I_OUT = (DM / 64) * (DM / 64), I_G = (DM / 64) * (FFN / 64), I_DN = (FFN / 64) * (DM / 64);
constexpr int I_LAYER = I_IN + I_OUT + 2 * I_G + I_DN, I_ALL = NLAYER * I_LAYER;
#ifndef CVT_NT
#define CVT_NT 1
#endif
#if CVT_NT
#define CVT_LD(p) __builtin_nontemporal_load(p)
#else
#define CVT_LD(p) (*(p))
#endif
#ifndef CVT_NTS
#define CVT_NTS 0
#endif
#if CVT_NTS
#define CVT_ST(p, v) __builtin_nontemporal_store((v), (p))
#else
#define CVT_ST(p, v) (*(p) = (v))
#endif
#if 0
#define CVT_LD(p) (*(p))
#endif
struct CvtItem { const float* src; bf16* dst; const float* gain; int N, K, rbase; };
__device__ __forceinline__ CvtItem cvt_decode(const float* const* in, unsigned char* ws, int it) {
    const int l = it >= I_LAYER ? 1 : 0; int r = it - l * I_LAYER;
    unsigned char* wl = ws + WS_W + (size_t)l * WL_STRIDE;
    const float* W; bf16* WT; const float* gn = nullptr; int K, N, mode;
    if (r < I_IN) { W = in[5] + (size_t)l * DM * INC; WT = (bf16*)(wl + WL_IN); K = DM; N = INC; mode = 0; gn = in[11] + l * DM; }
    else if ((r -= I_IN) < I_OUT) { W = in[6] + (size_t)l * DM * DM; WT = (bf16*)(wl + WL_OUT); K = DM; N = DM; mode = 0; }
    else if ((r -= I_OUT) < I_G) { W = in[15] + (size_t)l * DM * FFN; WT = (bf16*)(wl + WL_GU); K = DM; N = FFN; mode = 1; gn = in[13] + l * DM; }
    else if ((r -= I_G) < I_G) { W = in[16] + (size_t)l * DM * FFN; WT = (bf16*)(wl + WL_GU); K = DM; N = FFN; mode = 2; gn = in[13] + l * DM; }
    else { r -= I_G; W = in[17] + (size_t)l * FFN * DM; WT = (bf16*)(wl + WL_DN); K = FFN; N = DM; mode = 0; }
    const int nblk = N >> 6, kb = r / nblk, nb = r - kb * nblk, k0 = kb << 6, n0 = nb << 6;
    CvtItem c; c.N = N; c.K = K; c.src = W + (size_t)k0 * N + n0; c.dst = WT + k0; c.gain = gn ? gn + k0 : nullptr;
    c.rbase = (mode == 0) ? n0 : (2 * (n0 & ~127) + (n0 & 127) + (mode == 2 ? 128 : 0));
    return c;
}
__device__ __forceinline__ void cvt_load(f32x4 (&v)[16], float& gq, const CvtItem& c, int lane) {
    const int kq = lane >> 4, nq = lane & 15;
    gq = c.gain ? c.gain[lane] : 1.0f;
#pragma unroll
    for (int it = 0; it < 16; ++it) v[it] = CVT_LD((const GAS f32x4*)(c.src + (size_t)(4 * it + kq) * c.N + 4 * nq));
}
#ifndef WMASK_BITS
#define WMASK_BITS 2
#endif
#ifndef WMASK_FFN_ONLY
#define WMASK_FFN_ONLY 1
#endif
constexpr int CVT_SCR = 9216 + 256;
__device__ __forceinline__ void cvt_finish(const f32x4 (&v)[16], const float gq, const CvtItem& c, LAS unsigned char* scr, int lane) {
    const int kq = lane >> 4, nq = lane & 15;
    LAS float* gs = (LAS float*)(scr + 9216);
    gs[lane] = gq; LDS_WAIT(); asm volatile("" ::: "memory");
#pragma unroll
    for (int it = 0; it < 16; ++it) { const int k = 4 * it + kq; const float gk = gs[k];
        const unsigned p01 = cvtpk(v[it][0] * gk, v[it][1] * gk), p23 = cvtpk(v[it][2] * gk, v[it][3] * gk);
        LAS unsigned short* d = (LAS unsigned short*)(scr + (4 * nq) * 144 + k * 2);
        d[0] = (unsigned short)(p01 & 0xffffu); d[72] = (unsigned short)(p01 >> 16); d[144] = (unsigned short)(p23 & 0xffffu); d[216] = (unsigned short)(p23 >> 16); }
    LDS_WAIT(); asm volatile("" ::: "memory");
#pragma unroll
    for (int jj = 0; jj < 8; ++jj) { const int n = 8 * jj + (lane >> 3), kc = lane & 7;
        v4u o = *(const LAS v4u*)(scr + n * 144 + kc * 16);
#if WMASK_BITS
        { const bool ffn_ = WMASK_FFN_ONLY ? (c.N == FFN || c.K == FFN) : true;
          const unsigned hb_ = ffn_ ? (1u << (WMASK_BITS - 1)) * 0x00010001u : 0u, mk_ = ffn_ ? ~(((1u << WMASK_BITS) - 1u) * 0x00010001u) : 0xffffffffu;
          o.x = (o.x + hb_) & mk_; o.y = (o.y + hb_) & mk_; o.z = (o.z + hb_) & mk_; o.w = (o.w + hb_) & mk_; }
#endif
        CVT_ST((GAS v4u*)(c.dst + (size_t)(c.rbase + n) * c.K + 8 * kc), o); }
    LDS_WAIT(); asm volatile("" ::: "memory");
}
#ifndef CVT_DEPTH
#define CVT_DEPTH 2
#endif
template <int DEPTH = CVT_DEPTH>
__device__ __forceinline__ void cvt_range(const float* const* in, unsigned char* ws, int lo, int hi, int iw, int stride, LAS unsigned char* scr, int lane, const bool rev = false) {
    int it = lo + iw; if (it >= hi) return;
    const int flip = lo + hi - 1;
#define CVT_ID(x) (rev ? flip - (x) : (x))
    if constexpr (DEPTH == 3) {
    f32x4 va[16], vb[16], vc[16]; float ga = 1.f, gb = 1.f, gc = 1.f;
    CvtItem ca = cvt_decode(in, ws, CVT_ID(it)), cb = ca, cc = ca;
    cvt_load(va, ga, ca, lane);
    int i1 = it + stride; bool h1 = i1 < hi;
    if (h1) { cb = cvt_decode(in, ws, CVT_ID(i1)); cvt_load(vb, gb, cb, lane); }
#pragma unroll 1
    for (;;) {
        int i2 = i1 + stride; bool h2 = h1 && i2 < hi;
        if (h2) { cc = cvt_decode(in, ws, CVT_ID(i2)); cvt_load(vc, gc, cc, lane); }
        cvt_finish(va, ga, ca, scr, lane);
        if (!h1) break;
        int i3 = i2 + stride; bool h3 = h2 && i3 < hi;
        if (h3) { ca = cvt_decode(in, ws, CVT_ID(i3)); cvt_load(va, ga, ca, lane); }
        cvt_finish(vb, gb, cb, scr, lane);
        if (!h2) break;
        int i4 = i3 + stride; bool h4 = h3 && i4 < hi;
        if (h4) { cb = cvt_decode(in, ws, CVT_ID(i4)); cvt_load(vb, gb, cb, lane); }
        cvt_finish(vc, gc, cc, scr, lane);
        if (!h3) break;
        i1 = i4; h1 = h4;
    }
    } else {
    f32x4 va[16], vb[16]; float ga = 1.f, gb = 1.f;
    CvtItem ca = cvt_decode(in, ws, CVT_ID(it)), cb = ca;
    cvt_load(va, ga, ca, lane);
#pragma unroll 1
    for (;;) {
        int nx = it + stride; bool hn = nx < hi;
        if (hn) { cb = cvt_decode(in, ws, CVT_ID(nx)); cvt_load(vb, gb, cb, lane); }
        cvt_finish(va, ga, ca, scr, lane);
        if (!hn) break;
        it = nx; nx = it + stride; hn = nx < hi;
        if (hn) { ca = cvt_decode(in, ws, CVT_ID(nx)); cvt_load(va, ga, ca, lane); }
        cvt_finish(vb, gb, cb, scr, lane);
        if (!hn) break;
        it = nx;
    }
    }
#undef CVT_ID
}
#ifndef CVT_W_A0
#define CVT_W_A0 8
#endif
#ifndef CVT_W_C0
#define CVT_W_C0 8
#endif
#ifndef CVT_W_A1
#define CVT_W_A1 8
#endif
#ifndef CVT_W_C1
#define CVT_W_C1 8
#endif
#ifndef CJ_TA0
#define CJ_TA0 23000
#endif
#ifndef CJ_TC0
#define CJ_TC0 29768
#endif
#ifndef CJ_TA1
#define CJ_TA1 14008
#endif
#ifndef CJ_TC1
#define CJ_TC1 11008
#endif
constexpr int CJ_E1 = I_LAYER + I_IN + I_OUT + 2 * I_G;
constexpr int CJ_C0 = CJ_E1 - CJ_TA1, CJ_A0 = CJ_C0 - CJ_TC0, CJ_P1 = CJ_A0 - CJ_TA0, CJ_P2 = I_ALL - CJ_TC1;
static_assert(CJ_P1 >= I_IN && CJ_A0 >= I_IN + I_OUT + 2 * I_G && CJ_C0 >= I_LAYER + I_IN + I_OUT && CJ_P2 >= CJ_E1 && CJ_TA0 >= 0 && CJ_TC0 >= 0 && CJ_TA1 >= 0 && CJ_TC1 >= 0, "conversion schedule");
constexpr int REM_A = ((MT / 256) * (INC / 256)) % 256, REM_C = ((MT / 256) * (NGU / 256)) % 256;

#ifndef NRM_NT
#define NRM_NT 0
#endif
#if NRM_NT
#define NRM_LD(p) __builtin_nontemporal_load(p)
#define NRM_ST(p, v) __builtin_nontemporal_store((v), (p))
#else
#define NRM_LD(p) (*(p))
#define NRM_ST(p, v) (*(p) = (v))
#endif
template <bool HAS_MF, bool XIN16, bool XOUT16>
__device__ __forceinline__ void norm_rows(const bool HAS_NEXT, const float* xp_in, bf16* xb, const bf16* mf, const float* gpost, float* xout, float* rs, int bx, int wave, int lane_in) {
    f32x4 g[16];
    if (HAS_MF) {
#pragma unroll
        for (int j = 0; j < 16; ++j) g[j] = ((const GAS f32x4*)gpost)[lane_in + 64 * j];
    }
#pragma unroll 1
    for (int it = 0; it < 4; ++it) {
        const int row = (bx * NWAVES + wave) + it * 2048;
        int lane = lane_in; asm volatile("" : "+v"(lane));
        f32x4 x[16]; v2u xx[16], mm[16];
        if (XIN16) {
#pragma unroll
            for (int j = 0; j < 16; ++j) xx[j] = NRM_LD(((const GAS v2u*)(xb + (size_t)row * DM)) + lane + 64 * j);
        } else {
#pragma unroll
            for (int j = 0; j < 16; ++j) x[j] = NRM_LD(((const GAS f32x4*)(xp_in + (size_t)row * DM)) + lane + 64 * j);
        }
        if (HAS_MF) {
#pragma unroll
            for (int j = 0; j < 16; ++j) mm[j] = NRM_LD(((const GAS v2u*)(mf + (size_t)row * DM)) + lane + 64 * j);
        }
        if (XIN16) {
#pragma unroll
            for (int j = 0; j < 16; ++j) x[j] = (f32x4){bflo(xx[j].x), bfhi(xx[j].x), bflo(xx[j].y), bfhi(xx[j].y)};
        }
        if (HAS_MF) {
            float ss = 0.f;
#pragma unroll
            for (int j = 0; j < 16; ++j) { const float a = bflo(mm[j].x), b = bfhi(mm[j].x), c = bflo(mm[j].y), d = bfhi(mm[j].y); ss += (a * a + b * b) + (c * c + d * d); }
            const float r1 = 1.0f / sqrtf(wave_sum(ss) * (1.0f / DM) + EPS);
#pragma unroll
            for (int j = 0; j < 16; ++j) { const f32x4 m = (f32x4){bflo(mm[j].x), bfhi(mm[j].x), bflo(mm[j].y), bfhi(mm[j].y)};
                x[j] += m * r1 * g[j]; }
        }
        if (XOUT16) {
#pragma unroll
            for (int j = 0; j < 16; ++j) { v2u o; o.x = cvtpk(x[j][0], x[j][1]); o.y = cvtpk(x[j][2], x[j][3]); NRM_ST(((GAS v2u*)(xb + (size_t)row * DM)) + lane + 64 * j, o); }
        } else {
#pragma unroll
            for (int j = 0; j < 16; ++j) ((GAS f32x4*)(xout + (size_t)row * DM))[lane + 64 * j] = x[j];
        }
        if (HAS_NEXT) {
            float s2 = 0.f;
#pragma unroll
            for (int j = 0; j < 16; ++j) s2 += (x[j][0] * x[j][0] + x[j][1] * x[j][1]) + (x[j][2] * x[j][2] + x[j][3] * x[j][3]);
            const float r2 = 1.0f / sqrtf(wave_sum(s2) * (1.0f / DM) + EPS);
            if (lane == 0) rs[row] = r2;
        }
    }
}

template <bool HAS_MF, bool XIN16, bool XOUT16>
__device__ __forceinline__ void norm_sample_row(const bool HAS_NEXT, const float* xs_in, bf16* xb, const bf16* slabs, const float* gpost, float* xout, float* rs, LAS float* red, int bx, int tid) {
    const int col = tid * 8, wave = tid >> 6, lane = tid & 63;
    const size_t ro = (size_t)bx * DM + col;
    f32x4 x0, x1;
    if (XIN16) { const v4u xx = *(const GAS v4u*)(xb + (size_t)NPR * DM + ro); x0 = (f32x4){bflo(xx.x), bfhi(xx.x), bflo(xx.y), bfhi(xx.y)}; x1 = (f32x4){bflo(xx.z), bfhi(xx.z), bflo(xx.w), bfhi(xx.w)}; }
    else { x0 = *(const GAS f32x4*)(xs_in + ro); x1 = *(const GAS f32x4*)(xs_in + ro + 4); }
    if (HAS_MF) {
        f32x4 m0 = {0.f, 0.f, 0.f, 0.f}, m1 = m0;
        v4u sl[16];
#pragma unroll
        for (int s = 0; s < 16; ++s) sl[s] = *(const GAS v4u*)(slabs + (size_t)s * NSM * DM + ro);
#pragma unroll
        for (int s = 0; s < 16; ++s) { m0 += (f32x4){bflo(sl[s].x), bfhi(sl[s].x), bflo(sl[s].y), bfhi(sl[s].y)}; m1 += (f32x4){bflo(sl[s].z), bfhi(sl[s].z), bflo(sl[s].w), bfhi(sl[s].w)}; }
        float ss = (m0[0] * m0[0] + m0[1] * m0[1]) + (m0[2] * m0[2] + m0[3] * m0[3]) + (m1[0] * m1[0] + m1[1] * m1[1]) + (m1[2] * m1[2] + m1[3] * m1[3]);
        ss = wave_sum(ss);
        if (lane == 0) red[wave] = ss;
        __syncthreads();
        float tot = 0.f;
#pragma unroll
        for (int w = 0; w < 8; ++w) tot += red[w];
        const float r1 = 1.0f / sqrtf(tot * (1.0f / DM) + EPS);
        const f32x4 g0 = *(const GAS f32x4*)(gpost + col), g1 = *(const GAS f32x4*)(gpost + col + 4);
        x0 += m0 * r1 * g0; x1 += m1 * r1 * g1;
    }
    if (XOUT16) { v4u o; o.x = cvtpk(x0[0], x0[1]); o.y = cvtpk(x0[2], x0[3]); o.z = cvtpk(x1[0], x1[1]); o.w = cvtpk(x1[2], x1[3]); *(GAS v4u*)(xb + (size_t)NPR * DM + ro) = o; }
    else { *(GAS f32x4*)(xout + (size_t)NPR * DM + ro) = x0; *(GAS f32x4*)(xout + (size_t)NPR * DM + ro + 4) = x1; }
    if (HAS_NEXT) {
        float s2 = (x0[0] * x0[0] + x0[1] * x0[1]) + (x0[2] * x0[2] + x0[3] * x0[3]) + (x1[0] * x1[0] + x1[1] * x1[1]) + (x1[2] * x1[2] + x1[3] * x1[3]);
        s2 = wave_sum(s2);
        if (lane == 0) red[8 + wave] = s2;
        __syncthreads();
        float tot = 0.f;
#pragma unroll
        for (int w = 0; w < 8; ++w) tot += red[8 + w];
        if (tid == 0) rs[NPR + bx] = 1.0f / sqrtf(tot * (1.0f / DM) + EPS);
    }
    __syncthreads();
}

constexpr int KS_STRIDE = 144, VT_STRIDE = 528, ATT_VT_OFF = 256 * KS_STRIDE;
#define MFMA32(a, b, c) __builtin_amdgcn_mfma_f32_32x32x16_bf16((a), (b), (c), 0, 0, 0)
__device__ __forceinline__ void attn_loadq(bf16x8 (&qf)[4], const bf16* qptr, int lane) {
    const int hi = lane >> 5;
#pragma unroll
    for (int ks = 0; ks < 4; ++ks) qf[ks] = *(const GAS bf16x8*)(qptr + ks * 16 + hi * 8);
}
__device__ __forceinline__ void attn_item(const LAS unsigned char* Ks, const LAS unsigned char* Vt, const bf16x8 (&qf)[4], int qi, float sink, bf16* optr, int kb0, bool n0, int lane) {
    const int r32 = lane & 31, hi = lane >> 5;
    f32x16 s[5];
#pragma unroll
    for (int kk = 0; kk < 5; ++kk) { f32x16 a = {};
#pragma unroll
        for (int ks = 0; ks < 4; ++ks) { const bf16x8 kf = *(const LAS bf16x8*)(Ks + (32 * (kb0 + kk) + r32) * KS_STRIDE + (16 * ks + 8 * hi) * 2); a = MFMA32(kf, qf[ks], a); }
        s[kk] = a; }
    float mx = sink;
#pragma unroll
    for (int kk = 0; kk < 5; ++kk)
#pragma unroll
        for (int r = 0; r < 16; ++r) { const int j = 32 * (kb0 + kk) + crow(r, hi); const bool ok = (j > qi) && (j <= qi + 128) && (!n0 || j >= 128);
            const float v = ok ? s[kk][r] : -INFINITY; s[kk][r] = v; mx = fmaxf(mx, v); }
    mx = fmaxf(mx, __shfl_xor(mx, 32));
    float l = 0.f;
#pragma unroll
    for (int kk = 0; kk < 5; ++kk)
#pragma unroll
        for (int r = 0; r < 16; ++r) { const float p = __builtin_amdgcn_exp2f((s[kk][r] - mx) * LOG2E); s[kk][r] = p; l += p; }
    l += __shfl_xor(l, 32);
    l += __builtin_amdgcn_exp2f((sink - mx) * LOG2E);
    f32x16 o[2] = {{}, {}};
#pragma unroll
    for (int kk = 0; kk < 5; ++kk)
#pragma unroll
        for (int si = 0; si < 2; ++si) { v4u pw; pw.x = cvtpk(s[kk][8 * si + 0], s[kk][8 * si + 1]); pw.y = cvtpk(s[kk][8 * si + 2], s[kk][8 * si + 3]); pw.z = cvtpk(s[kk][8 * si + 4], s[kk][8 * si + 5]); pw.w = cvtpk(s[kk][8 * si + 6], s[kk][8 * si + 7]);
            const bf16x8 pf = __builtin_bit_cast(bf16x8, pw);
#pragma unroll
            for (int db = 0; db < 2; ++db) { const LAS unsigned char* vp = Vt + (32 * db + r32) * VT_STRIDE + (32 * (kb0 + kk) + 16 * si + 4 * hi) * 2;
                const v2u lo = *(const LAS v2u*)vp, hh = *(const LAS v2u*)(vp + 16);
                v4u vw; vw.x = lo.x; vw.y = lo.y; vw.z = hh.x; vw.w = hh.y;
                o[db] = MFMA32(__builtin_bit_cast(bf16x8, vw), pf, o[db]); } }
    const float inv = 1.0f / l;
#pragma unroll
    for (int db = 0; db < 2; ++db)
#pragma unroll
        for (int g4 = 0; g4 < 4; ++g4) { v2u w; w.x = cvtpk(o[db][4 * g4 + 0] * inv, o[db][4 * g4 + 1] * inv); w.y = cvtpk(o[db][4 * g4 + 2] * inv, o[db][4 * g4 + 3] * inv);
            *(GAS v2u*)(optr + 32 * db + 8 * g4 + 4 * hi) = w; }
}
__device__ __forceinline__ void vt_scatter(LAS unsigned char* Vt, int part, int key, v4u vv) {
#pragma unroll
    for (int e = 0; e < 8; ++e) { const unsigned w = vv[e >> 1]; *(LAS unsigned short*)(Vt + (part * 8 + e) * VT_STRIDE + key * 2) = (unsigned short)((e & 1) ? (w >> 16) : (w & 0xffffu)); }
}
__device__ __forceinline__ void attn_unit_prompt(LAS unsigned char* lds, const bf16* Z, bf16* MIX, const float* sinks, int unit, int tid, int wave, int lane) {
    const int kvh = unit & 3, n = (unit >> 2) & 15, b = unit >> 6;
    LAS unsigned char* Ks = lds; LAS unsigned char* Vt = lds + ATT_VT_OFF;
    const int keyrow0 = b * SEQL + 128 * (n - 1); const bool n0 = (n == 0);
#pragma unroll
    for (int i = 0; i < 4; ++i) { const int c = tid + 512 * i, key = c >> 3, part = c & 7;
        v4u kv = {0u, 0u, 0u, 0u}, vv = {0u, 0u, 0u, 0u};
        if (!(n0 && key < 128)) { const bf16* zr = Z + (size_t)(keyrow0 + key) * INC + kvh * 64 + part * 8; kv = *(const GAS v4u*)(zr + COL_K); vv = *(const GAS v4u*)(zr + COL_V); }
        *(LAS v4u*)(Ks + key * KS_STRIDE + part * 16) = kv; vt_scatter(Vt, part, key, vv); }
    __syncthreads();
    const int head = kvh * 8 + wave; const float sink = sinks[head];
    const size_t row0 = (size_t)b * SEQL + 128 * n + (lane & 31);
    bf16x8 qa[4], qb_[4];
    attn_loadq(qa, Z + row0 * INC + head * 64, lane);
#pragma unroll 1
    for (int qb = 0; qb < 4; qb += 2) {
        attn_loadq(qb_, Z + (row0 + 32 * (qb + 1)) * INC + head * 64, lane);
        attn_item(Ks, Vt, qa, 32 * qb + (lane & 31), sink, MIX + (row0 + 32 * qb) * DM + head * 64, qb, n0, lane);
        if (qb + 2 < 4) attn_loadq(qa, Z + (row0 + 32 * (qb + 2)) * INC + head * 64, lane);
        attn_item(Ks, Vt, qb_, 32 * (qb + 1) + (lane & 31), sink, MIX + (row0 + 32 * (qb + 1)) * DM + head * 64, qb + 1, n0, lane); }
    __syncthreads();
}
__device__ __forceinline__ void attn_unit_sample(LAS unsigned char* lds, const bf16* Z, bf16* MIX, const float* sinks, const float* stk, const float* stv  , int unit, int tid, int wave, int lane) {
    const int kvh = unit & 3, bs = unit >> 2;
    LAS unsigned char* Ks = lds; LAS unsigned char* Vt = lds + ATT_VT_OFF;
    for (int c = tid; c < 160 * 8; c += 512) { const int key = c >> 3, part = c & 7;
        v4u kv = {0u, 0u, 0u, 0u}, vv = {0u, 0u, 0u, 0u};
        if (key < 128) { const size_t o = (((size_t)bs * 128 + key) * 4 + kvh) * 64 + part * 8;
            const f32x4 k0 = *(const GAS f32x4*)(stk + o), k1 = *(const GAS f32x4*)(stk + o + 4), v0 = *(const GAS f32x4*)(stv + o), v1 = *(const GAS f32x4*)(stv + o + 4);
            kv.x = cvtpk(k0[0], k0[1]); kv.y = cvtpk(k0[2], k0[3]); kv.z = cvtpk(k1[0], k1[1]); kv.w = cvtpk(k1[2], k1[3]);
            vv.x = cvtpk(v0[0], v0[1]); vv.y = cvtpk(v0[2], v0[3]); vv.z = cvtpk(v1[0], v1[1]); vv.w = cvtpk(v1[2], v1[3]); }
        else if (key < 136) { const bf16* zr = Z + (size_t)(NPR + bs * DSEQ + (key - 128)) * INC + kvh * 64 + part * 8; kv = *(const GAS v4u*)(zr + COL_K); vv = *(const GAS v4u*)(zr + COL_V); }
        *(LAS v4u*)(Ks + key * KS_STRIDE + part * 16) = kv; vt_scatter(Vt, part, key, vv); }
    __syncthreads();
    if (wave < 2) { const int q = lane & 31, head = kvh * 8 + wave * 4 + (q >> 3), t = q & 7; const size_t row = (size_t)NPR + bs * DSEQ + t;
        bf16x8 qs[4]; attn_loadq(qs, Z + row * INC + head * 64, lane);
        attn_item(Ks, Vt, qs, t, sinks[head], MIX + row * DM + head * 64, 0, false, lane); }
    __syncthreads();
}
constexpr int VN_STRIDE = 272, GM_RS_OFF = 128 * VN_STRIDE;
struct GmlpRaw { v4u raw[4]; f32x4 g0, g1; };
__device__ __forceinline__ void gmlp_issue(GmlpRaw& R, const bf16* Z, const float* gnorm, int unit, int tid) {
    const int hh = unit & 15, R0 = (unit >> 4) * 128;
#pragma unroll
    for (int i = 0; i < 4; ++i) { const int c = tid + 512 * i, s = c >> 4, ep = c & 15; R.raw[i] = *(const GAS v4u*)(Z + (size_t)(R0 + s) * INC + COL_GV + hh * 128 + ep * 8); }
    const int ep = tid & 15;
    R.g0 = *(const GAS f32x4*)(gnorm + hh * 128 + ep * 8); R.g1 = *(const GAS f32x4*)(gnorm + hh * 128 + ep * 8 + 4);
}
__device__ __forceinline__ void gmlp_finish(const GmlpRaw& R, LAS unsigned char* lds, const bf16* Z, bf16* MIX, const float* ssq, const bf16* wtril, const float* gbias, int unit, bool need_rs, int tid, int wave, int lane) {
    const int hh = unit & 15, R0 = (unit >> 4) * 128;
    LAS unsigned char* vnT = lds; LAS float* rsl = (LAS float*)(lds + GM_RS_OFF);
    const int r32 = lane & 31, hi = lane >> 5, tb = wave >> 1, eb0 = (wave & 1) * 2, t = 32 * tb + r32;
    const int ep = tid & 15, nks = 2 * tb + 2;
    const bf16* wrow = wtril + ((size_t)hh * 128 + t) * 128;
    bf16x8 wf[8];
#pragma unroll
    for (int ks = 0; ks < 8; ++ks) wf[ks] = (ks < nks) ? *(const GAS bf16x8*)(wrow + 16 * ks + 8 * hi) : (bf16x8){0, 0, 0, 0, 0, 0, 0, 0};
    const float bias = gbias[hh * 128 + t];
    const bf16* urow = Z + (size_t)(R0 + t) * INC + COL_U + hh * 128; bf16* orow = MIX + (size_t)(R0 + t) * DM + QCOLS + hh * 128;
    v2u uu[2][4];
#pragma unroll
    for (int eb = 0; eb < 2; ++eb)
#pragma unroll
        for (int g4 = 0; g4 < 4; ++g4) uu[eb][g4] = *(const GAS v2u*)(urow + 32 * (eb0 + eb) + 8 * g4 + 4 * hi);
    if (need_rs) {
        if (tid < 128) { const GAS f32x4* p = (const GAS f32x4*)(ssq + (size_t)(R0 + tid) * 32); f32x4 v[8];
#pragma unroll
            for (int i = 0; i < 8; ++i) v[i] = p[i];
            float s = 0.f;
#pragma unroll
            for (int i = 0; i < 8; ++i) s += (v[i][0] + v[i][1]) + (v[i][2] + v[i][3]);
            rsl[tid] = 1.0f / sqrtf(s * (1.0f / GMW) + EPS); }
        __syncthreads();
    }
#pragma unroll
    for (int i = 0; i < 4; ++i) { const int c = tid + 512 * i, s = c >> 4;
        const float rs = rsl[s];
        const unsigned p0 = cvtpk(bflo(R.raw[i].x) * rs * R.g0[0], bfhi(R.raw[i].x) * rs * R.g0[1]), p1 = cvtpk(bflo(R.raw[i].y) * rs * R.g0[2], bfhi(R.raw[i].y) * rs * R.g0[3]);
        const unsigned p2 = cvtpk(bflo(R.raw[i].z) * rs * R.g1[0], bfhi(R.raw[i].z) * rs * R.g1[1]), p3 = cvtpk(bflo(R.raw[i].w) * rs * R.g1[2], bfhi(R.raw[i].w) * rs * R.g1[3]);
        LAS unsigned short* d = (LAS unsigned short*)(vnT + (ep * 8) * VN_STRIDE + s * 2);
        d[0 * 136] = (unsigned short)(p0 & 0xffffu); d[1 * 136] = (unsigned short)(p0 >> 16); d[2 * 136] = (unsigned short)(p1 & 0xffffu); d[3 * 136] = (unsigned short)(p1 >> 16);
        d[4 * 136] = (unsigned short)(p2 & 0xffffu); d[5 * 136] = (unsigned short)(p2 >> 16); d[6 * 136] = (unsigned short)(p3 & 0xffffu); d[7 * 136] = (unsigned short)(p3 >> 16); }
    __syncthreads();
    f32x16 a0 = {}, a1 = {};
#pragma unroll
    for (int ks = 0; ks < 8; ++ks) { if (ks < nks) {
        const bf16x8 v0 = *(const LAS bf16x8*)(vnT + (32 * eb0 + r32) * VN_STRIDE + (16 * ks + 8 * hi) * 2), v1 = *(const LAS bf16x8*)(vnT + (32 * (eb0 + 1) + r32) * VN_STRIDE + (16 * ks + 8 * hi) * 2);
        a0 = MFMA32(v0, wf[ks], a0); a1 = MFMA32(v1, wf[ks], a1); } }
#pragma unroll
    for (int eb = 0; eb < 2; ++eb)
#pragma unroll
        for (int g4 = 0; g4 < 4; ++g4) { const int e0 = 32 * (eb0 + eb) + 8 * g4 + 4 * hi; const v2u u2 = uu[eb][g4];
            const float s0 = (eb ? a1[4 * g4 + 0] : a0[4 * g4 + 0]) + bias, s1 = (eb ? a1[4 * g4 + 1] : a0[4 * g4 + 1]) + bias, s2 = (eb ? a1[4 * g4 + 2] : a0[4 * g4 + 2]) + bias, s3 = (eb ? a1[4 * g4 + 3] : a0[4 * g4 + 3]) + bias;
            v2u w; w.x = cvtpk(bflo(u2.x) * s0, bfhi(u2.x) * s1); w.y = cvtpk(bflo(u2.y) * s2, bfhi(u2.y) * s3);
            *(GAS v2u*)(orow + e0) = w; }
    __syncthreads();
}
__device__ __forceinline__ void gmlp_sample_item(LAS unsigned char* lds, const bf16* Z, bf16* MIX, const float* ssq, const float* gnorm, const float* wsp  , const float* gbias, float* out_sg, int item, int tid) {
    const int bs = item >> 3, part = item & 7;
    LAS float* rsl = (LAS float*)lds;
    if (tid < 8) { const GAS f32x4* p = (const GAS f32x4*)(ssq + (size_t)(NPR + bs * DSEQ + tid) * 32); float s = 0.f;
#pragma unroll
        for (int i = 0; i < 8; ++i) { const f32x4 v = p[i]; s += (v[0] + v[1]) + (v[2] + v[3]); }
        rsl[tid] = 1.0f / sqrtf(s * (1.0f / GMW) + EPS); }
    __syncthreads();
    const int t = tid >> 6, col = part * 256 + (tid & 63) * 4, hh = col >> 7;
    const f32x4 g = *(const GAS f32x4*)(gnorm + col);
    f32x4 acc = {0.f, 0.f, 0.f, 0.f};
    const float* wr = wsp + ((size_t)hh * 128 + t) * 128;
    v2u rawv[8]; float wv[8];
#pragma unroll
    for (int s = 0; s < 8; ++s) { if (s <= t) { rawv[s] = *(const GAS v2u*)(Z + ((size_t)NPR + bs * DSEQ + s) * INC + COL_GV + col); wv[s] = wr[s]; } else { rawv[s] = (v2u){0u, 0u}; wv[s] = 0.f; } }
#pragma unroll
    for (int s = 0; s < 8; ++s) { if (s <= t) { const float rs = rsl[s];
        f32x4 vn; vn[0] = bflo(rawv[s].x) * rs * g[0]; vn[1] = bfhi(rawv[s].x) * rs * g[1]; vn[2] = bflo(rawv[s].y) * rs * g[2]; vn[3] = bfhi(rawv[s].y) * rs * g[3];
        acc += vn * wv[s];
        if (s == t) *(GAS f32x4*)(out_sg + (size_t)(bs * DSEQ + t) * GMW + col) = vn; } }
    const float bias = gbias[hh * 128 + t];
    const size_t row = (size_t)NPR + bs * DSEQ + t; const v2u uu = *(const GAS v2u*)(Z + row * INC + COL_U + col);
    v2u w; w.x = cvtpk(bflo(uu.x) * (acc[0] + bias), bfhi(uu.x) * (acc[1] + bias)); w.y = cvtpk(bflo(uu.y) * (acc[2] + bias), bfhi(uu.y) * (acc[3] + bias));
    *(GAS v2u*)(MIX + row * DM + QCOLS + col) = w;
    __syncthreads();
}

__device__ __forceinline__ int idle_rank(pg8::StaticOrder S, int rnd, int bx, int lane, int& n_idle) {
    int rank = 0; n_idle = 0;
#pragma unroll
    for (int k = 0; k < 4; ++k) { S.c = lane + 64 * k; pg8::Unit u; const bool busy = S.next(rnd, u);
        const unsigned long long m = __ballot(!busy);
        n_idle += __popcll(m);
        if (bx >= 64 * (k + 1)) rank += __popcll(m); else if (bx >= 64 * k) rank += __popcll(m & ((1ull << (bx - 64 * k)) - 1ull)); }
    return rank;
}
#ifndef CVQ
#define CVQ 0
#endif
constexpr int CW_QHEAD = 8192, CW_QDONE = 8192 + 64;
__device__ __forceinline__ void cvt_queue(const float* const* in, unsigned char* ws, gu32* ctl, int p, int n_busy, int hard, LAS unsigned char* scr, int lane) {
    gu32* head = ctl + CW_QHEAD; gu32* done = ctl + CW_QDONE + 64 * p;
#pragma unroll 1
    for (;;) {
        unsigned d = 0, h = 0;
        if (lane == 0) { d = __hip_atomic_load(done, RLX_AGENT); h = __hip_atomic_load(head, RLX_AGENT); }
        d = (unsigned)__builtin_amdgcn_readfirstlane((int)d); h = (unsigned)__builtin_amdgcn_readfirstlane((int)h);
        const bool running = d < (unsigned)n_busy;
        const int cur = CJ_P1 + (int)h;
        if (cur >= I_ALL) break;
        if (!running && cur >= hard) break;
        const int qb = running ? 2 : 1;
        unsigned t = 0; if (lane == 0) t = __hip_atomic_fetch_add(head, (unsigned)qb, RLX_AGENT);
        t = (unsigned)__builtin_amdgcn_readfirstlane((int)t);
        const int id = CJ_P1 + (int)t; if (id >= I_ALL) break;
        cvt_range(in, ws, id, id + qb < I_ALL ? id + qb : I_ALL, 0, 1, scr, lane);
    }
}
#ifndef DYN_TAIL
#define DYN_TAIL 1
#endif
#ifndef DYN_ROUNDS
#define DYN_ROUNDS 0
#endif
#ifndef DYN_ROUNDS_A
#define DYN_ROUNDS_A DYN_ROUNDS
#endif
#ifndef DYN_ROUNDS_C
#define DYN_ROUNDS_C DYN_ROUNDS
#endif
#ifndef CVT_CLAIM
#define CVT_CLAIM 24
#endif
#ifndef DYN_PIECES
#define DYN_PIECES 1
#endif
constexpr int CW_TAILQ = 9216, CW_CVTQ = 9728, CW_PIECEQ = 10240;
#ifndef CVT_SLOW_W
#define CVT_SLOW_W 2
#endif
#ifndef CVT_THR_A0
#define CVT_THR_A0 0
#endif
#ifndef CVT_THR_C0
#define CVT_THR_C0 0
#endif
#ifndef CVT_THR_A1
#define CVT_THR_A1 0
#endif
#ifndef CVT_THR_C1
#define CVT_THR_C1 0
#endif
__device__ __forceinline__ void cvt_claim(const float* const* in, unsigned char* ws, gu32* head, volatile LAS unsigned* slot, int lo, int hi, LAS unsigned char* scr, int tid, int wave, int lane, gu32* fin, int thr) {
    (void)fin; (void)thr;
    unsigned nxt = 0u;
    if (tid == 0) nxt = __hip_atomic_fetch_add(head, (unsigned)CVT_CLAIM, RLX_AGENT);
#pragma unroll 1
    for (;;) {
        if (tid == 0) *slot = nxt;
        __syncthreads(); const int b = lo + __builtin_amdgcn_readfirstlane((int)*slot); __syncthreads();
        if (b >= hi) break;
        if (tid == 0) nxt = __hip_atomic_fetch_add(head, (unsigned)CVT_CLAIM, RLX_AGENT);
        cvt_range<2>(in, ws, b, (b + CVT_CLAIM < hi) ? b + CVT_CLAIM : hi, wave, NWAVES, scr, lane);
    }
}
struct Args { const float* in[20]; float* out; unsigned char* ws; int ph_lo, ph_hi; };
constexpr int N_PHASES = 1 + 8 * NLAYER;
__global__ void __launch_bounds__(NWAVES * 64, 2) fwd_kernel(Args args) {
    extern __shared__ __attribute__((aligned(16))) unsigned char lds_raw[];
    LAS unsigned char* lds = (LAS unsigned char*)lds_raw;
    volatile LAS unsigned* MISC = (volatile LAS unsigned*)(lds + MISC_OFF);
    constexpr int G = 256;
    const int bx = blockIdx.x; constexpr int NGW = G * NWAVES;
    __builtin_assume(bx >= 0 && bx < G);
    const int wave0 = __builtin_amdgcn_readfirstlane((int)threadIdx.x >> 6);
    unsigned char* ws = args.ws;
    gu32* ctl = (gu32*)(ws + WS_CTL);
    for (int u = threadIdx.x; u < (LDS_BYTES - LDSCTL_OFF) / 4; u += NWAVES * 64) ((LAS unsigned*)(lds + LDSCTL_OFF))[u] = 0u;
    __syncthreads();
    XcdBarrier bar; bar.bar = (unsigned*)(ctl + CW_BAR); bar.x = 0; bar.st = nullptr;
    if (!MK_PER_PHASE) bar = xcd_barrier_post((unsigned*)(ctl + CW_BAR), MISC + 8);
#if MK_PER_PHASE
    const int lo = args.ph_lo, hi = args.ph_hi;
#else
    constexpr int lo = 0, hi = N_PHASES;
#endif
#define IN(k) (lo <= (k) && (k) < hi)
#define PHASE_IDS int wv_p = wave0; asm volatile("" : "+s"(wv_p)); int ln_p; asm volatile("v_mbcnt_lo_u32_b32 %0, -1, 0\n\tv_mbcnt_hi_u32_b32 %0, -1, %0" : "=v"(ln_p)); const int tid = wv_p * 64 + ln_p, lane = tid & 63, wave = __builtin_amdgcn_readfirstlane(tid >> 6), gw = bx * NWAVES + wave; (void)lane; (void)gw; (void)wave; (void)tid
#ifdef PROBE_SKEW
#define SEAM(k) do { if (IN(k) && IN((k) + 1)) { if (threadIdx.x == 0) ((GAS unsigned long long*)(ws + WS_RS + 512 * 1024))[(k) * 256 + bx] = rt(); xcd_barrier(bar); } } while (0)
#else
#define SEAM(k) do { if (IN(k) && IN((k) + 1)) xcd_barrier(bar); } while (0)
#endif

    const float* x_prompt = args.in[0]; const float* x_sample = args.in[1];
    float* out = args.out;
    bf16* Hb = (bf16*)(ws + WS_H); bf16* Zb = (bf16*)(ws + WS_Z); bf16* MIXb = (bf16*)(ws + WS_MIX); bf16* Ab = (bf16*)(ws + WS_A); bf16* MFb = (bf16*)(ws + WS_MF);
    float* SSQ = (float*)(ws + WS_SSQ); bf16* HALO = (bf16*)(ws + WS_HALO); bf16* SLAB = (bf16*)(ws + WS_SLAB); bf16* XB = (bf16*)(ws + WS_XB); float* RS = (float*)(ws + WS_RS); bf16* TRIL = (bf16*)(ws + WS_TRIL);

    for (int rep = 0; rep < (RP(0) ? 2 : 1); ++rep) { if (rep) xcd_barrier(bar);
    if (IN(0) && !SK(0)) {
        { PHASE_IDS;
        LAS unsigned char* scr = lds + RING_OFF + wave * CVT_SCR;
#ifndef PRO_REV
#define PRO_REV 0
#endif
        cvt_range(args.in, ws, 0, CJ_P1, gw, NGW, scr, lane, PRO_REV != 0);
        if (CJ_P2 > CJ_E1) cvt_range(args.in, ws, CJ_E1, CJ_P2, gw, NGW, scr, lane);
        }
        PHASE_IDS;
        for (int i = bx * 512 + tid; i < NLAYER * 16 * 128 * 128 / 4; i += G * 512) { const f32x4 v = ((const GAS f32x4*)args.in[8])[i]; const int s0 = (i * 4) & 127, t = ((i * 4) >> 7) & 127;
            v2u o; o.x = cvtpk(s0 + 0 <= t ? v[0] : 0.f, s0 + 1 <= t ? v[1] : 0.f); o.y = cvtpk(s0 + 2 <= t ? v[2] : 0.f, s0 + 3 <= t ? v[3] : 0.f); ((GAS v2u*)TRIL)[i] = o; }
        norm_sample_row<false, false, true>(true, x_sample, XB, nullptr, nullptr, nullptr, RS, (LAS float*)(lds + 81920), bx, tid);
        norm_rows<false, false, true>(true, x_prompt, XB, nullptr, nullptr, nullptr, RS, bx, wave, lane);
    } }
    SEAM(0);
#pragma unroll 1
    for (int l = 0; l < NLAYER; ++l) {
        const int pb = 1 + 8 * l;
        unsigned char* wl = ws + WS_W + (size_t)l * WL_STRIDE;
        for (int rep = 0; rep < ((RP(1) && l == 0) ? 2 : 1); ++rep) { if (rep) xcd_barrier(bar);
        if (IN(pb + 0) && !SK(1)) {
            pg8::Gemm g{XB, (const bf16*)(wl + WL_IN), MT, INC, DM}; pg8::StaticOrder S; S.init(MT, INC, G, bx, DM);
            pg8::EpiIn E{Zb, SSQ, out + O_PK + (size_t)l * 131072, out + O_PV + (size_t)l * 131072, out + O_SK + (size_t)l * 65536, out + O_SV + (size_t)l * 65536, RS, lds + LDSCTL_OFF + 1024};
#if DYN_TAIL
            { const int RF = S.nwg / G - DYN_ROUNDS_A, NT = S.nwg - RF * G; S.imax = RF;
              for (;;) { pg8::gemm_phase<pg8::EpiIn, pg8::StaticOrder, PG8_ALIGN, PG8_SP2>(lds + RING_OFF, g, S, E, wave0);
                  if (threadIdx.x == 0) MISC[12] = __hip_atomic_fetch_add(ctl + CW_TAILQ + 64 * (2 * l), 1u, RLX_AGENT);
                  __syncthreads(); const int t = __builtin_amdgcn_readfirstlane((int)MISC[12]); __syncthreads();
                  if (t >= NT) break;
                  S.c = t; S.i0 = RF; S.imax = 1; }
              PHASE_IDS; cvt_claim(args.in, ws, ctl + CW_CVTQ + 64 * (2 * l), MISC + 13, l == 0 ? CJ_P1 : CJ_C0, l == 0 ? CJ_A0 : CJ_E1, lds + RING_OFF + wave * CVT_SCR, tid, wave, lane, ctl + CW_TAILQ + 64 * (2 * l), l == 0 ? CVT_THR_A0 : CVT_THR_A1); }
#else
            pg8::gemm_phase<pg8::EpiIn, pg8::StaticOrder, PG8_ALIGN, PG8_SP2>(lds + RING_OFF, g, S, E, wave0);
#if CVQ
            { PHASE_IDS; pg8::Unit u_; if (S.next(3, u_) && tid == 0) __hip_atomic_fetch_add(ctl + CW_QDONE + 64 * (2 * l), 1u, RLX_AGENT);
              cvt_queue(args.in, ws, ctl, 2 * l, REM_A, l == 0 ? I_IN + I_OUT + 2 * I_G : CJ_E1, lds + RING_OFF + wave * CVT_SCR, lane); }
#else
            { pg8::Unit u_; if (!S.next(3, u_)) { PHASE_IDS; int n_idle; const int rk = idle_rank(S, 3, bx, lane, n_idle); const int nw_ = (l == 0) ? CVT_W_A0 : CVT_W_A1; if (wave < nw_) cvt_range(args.in, ws, l == 0 ? CJ_P1 : CJ_C0, l == 0 ? CJ_A0 : CJ_E1, rk * nw_ + wave, n_idle * nw_, lds + RING_OFF + wave * CVT_SCR, lane); } }
#endif
#endif
        }
        }
        SEAM(pb + 0);
        for (int rep = 0; rep < ((RP(2) && l == 0) ? 2 : 1); ++rep) { if (rep) xcd_barrier(bar);
        if (IN(pb + 1) && !SK(2)) {
            const float* sinks = args.in[7] + l * 32;
            const float* gnorm = args.in[10] + l * GMW; const float* gbias = args.in[9] + l * 2048; const bf16* wtril = TRIL + (size_t)l * 16 * 128 * 128;
            { PHASE_IDS;
            for (int u = bx; u < 256; u += G) attn_unit_prompt(lds, Zb, MIXb, sinks, u, tid, wave, lane);
            { GmlpRaw Ra, Rb;
              const int u0 = bx * 4;
              gmlp_issue(Ra, Zb, gnorm, u0, tid);
              gmlp_issue(Rb, Zb, gnorm, u0 + 1, tid); gmlp_finish(Ra, lds, Zb, MIXb, SSQ, wtril, gbias, u0, true, tid, wave, lane);
              gmlp_issue(Ra, Zb, gnorm, u0 + 2, tid); gmlp_finish(Rb, lds, Zb, MIXb, SSQ, wtril, gbias, u0 + 1, false, tid, wave, lane);
              gmlp_issue(Rb, Zb, gnorm, u0 + 3, tid); gmlp_finish(Ra, lds, Zb, MIXb, SSQ, wtril, gbias, u0 + 2, false, tid, wave, lane);
              gmlp_finish(Rb, lds, Zb, MIXb, SSQ, wtril, gbias, u0 + 3, false, tid, wave, lane); }
            }
            { PHASE_IDS;
            const float* stk = args.in[2] + (size_t)l * DBATCH * 128 * 256; const float* stv = args.in[3] + (size_t)l * DBATCH * 128 * 256;
            for (int u = bx; u < 128; u += G) attn_unit_sample(lds, Zb, MIXb, sinks, stk, stv, u, tid, wave, lane);
            for (int it = bx; it < 256; it += G) gmlp_sample_item(lds, Zb, MIXb, SSQ, gnorm, args.in[8] + (size_t)l * 16 * 128 * 128, gbias, out + O_SG + (size_t)l * NSM * GMW, it, tid);
            }
        }
        }
        SEAM(pb + 1);
        for (int rep = 0; rep < ((RP(3) && l == 0) ? 2 : 1); ++rep) { if (rep) xcd_barrier(bar);
        if (IN(pb + 2) && !SK(3)) {
            pg8::Gemm g{MIXb, (const bf16*)(wl + WL_OUT), MT, DM, DM}; pg8::SplitOrder S; S.init2(NPR, DM, G, bx, DM);
            pg8::EpiPlain E{MFb, DM, SLAB};
#if DYN_PIECES == 2
            S.pmode = 2;
            pg8::gemm_phase<pg8::EpiPlain, pg8::SplitOrder, PG8_ALIGN, PG8_SP2>(lds + RING_OFF, g, S, E, wave0);
#elif DYN_PIECES
            S.pmode = 0;
            for (;;) { pg8::gemm_phase<pg8::EpiPlain, pg8::SplitOrder, PG8_ALIGN, PG8_SP2>(lds + RING_OFF, g, S, E, wave0);
                if (threadIdx.x == 0) MISC[12] = __hip_atomic_fetch_add(ctl + CW_PIECEQ + 64 * (2 * l + 0), 1u, RLX_AGENT);
                __syncthreads(); const int t = __builtin_amdgcn_readfirstlane((int)MISC[12]); __syncthreads();
                if (t >= 256) break;
                S.c = t; S.pmode = 1; }
#else
            pg8::gemm_phase<pg8::EpiPlain, pg8::SplitOrder, PG8_ALIGN, PG8_SP2>(lds + RING_OFF, g, S, E, wave0);
#endif
        }
        }
        SEAM(pb + 2);
        for (int rep = 0; rep < ((RP(4) && l == 0) ? 2 : 1); ++rep) { if (rep) xcd_barrier(bar);
        if (IN(pb + 3) && !SK(4)) { PHASE_IDS;
            norm_sample_row<true, true, true>(true, nullptr, XB, SLAB, args.in[12] + l * DM, nullptr, RS, (LAS float*)(lds + 81920), bx, tid);
            norm_rows<true, true, true>(true, nullptr, XB, MFb, args.in[12] + l * DM, nullptr, RS, bx, wave, lane);
        }
        }
        SEAM(pb + 3);
        for (int rep = 0; rep < ((RP(5) && l == 0) ? 2 : 1); ++rep) { if (rep) xcd_barrier(bar);
        if (IN(pb + 4) && !SK(5)) {
            pg8::Gemm g{XB, (const bf16*)(wl + WL_GU), MT, NGU, DM}; pg8::StaticOrder S; S.init(MT, NGU, G, bx, DM);
            pg8::EpiGU E{Ab, HALO, args.in[18] + (size_t)l * 3 * FFN, args.in[19] + (size_t)l * FFN, args.in[4] + (size_t)l * DBATCH * 2 * FFN, out + O_PC + (size_t)l * NBATCH * 2 * FFN, out + O_SC + (size_t)l * DBATCH * 2 * FFN, lds + LDSCTL_OFF + 1024, RS};
#if DYN_TAIL
            { const int RF = S.nwg / G - DYN_ROUNDS_C, NT = S.nwg - RF * G; S.imax = RF;
              for (;;) { pg8::gemm_phase<pg8::EpiGU, pg8::StaticOrder, PG8_ALIGN, PG8_SP2>(lds + RING_OFF, g, S, E, wave0);
                  if (threadIdx.x == 0) MISC[12] = __hip_atomic_fetch_add(ctl + CW_TAILQ + 64 * (2 * l + 1), 1u, RLX_AGENT);
                  __syncthreads(); const int t = __builtin_amdgcn_readfirstlane((int)MISC[12]); __syncthreads();
                  if (t >= NT) break;
                  S.c = t; S.i0 = RF; S.imax = 1; }
              PHASE_IDS; cvt_claim(args.in, ws, ctl + CW_CVTQ + 64 * (2 * l + 1), MISC + 13, l == 0 ? CJ_A0 : CJ_P2, l == 0 ? CJ_C0 : I_ALL, lds + RING_OFF + wave * CVT_SCR, tid, wave, lane, ctl + CW_TAILQ + 64 * (2 * l + 1), l == 0 ? CVT_THR_C0 : CVT_THR_C1); }
#else
            pg8::gemm_phase<pg8::EpiGU, pg8::StaticOrder, PG8_ALIGN, PG8_SP2>(lds + RING_OFF, g, S, E, wave0);
#ifdef PROBE_SKEW
            if (threadIdx.x == 0) ((GAS unsigned long long*)(ws + WS_RS + 512 * 1024))[(16 + l) * 256 + bx] = rt();
#endif
#if CVQ
            { PHASE_IDS; pg8::Unit u_; if (S.next(11, u_) && tid == 0) __hip_atomic_fetch_add(ctl + CW_QDONE + 64 * (2 * l + 1), 1u, RLX_AGENT);
              cvt_queue(args.in, ws, ctl, 2 * l + 1, REM_C, l == 0 ? I_LAYER + I_IN + I_OUT : I_ALL, lds + RING_OFF + wave * CVT_SCR, lane); }
#else
            { pg8::Unit u_; if (!S.next(11, u_)) { PHASE_IDS; int n_idle; const int rk = idle_rank(S, 11, bx, lane, n_idle); const int nw_ = (l == 0) ? CVT_W_C0 : CVT_W_C1; if (wave < nw_) cvt_range(args.in, ws, l == 0 ? CJ_A0 : CJ_P2, l == 0 ? CJ_C0 : I_ALL, rk * nw_ + wave, n_idle * nw_, lds + RING_OFF + wave * CVT_SCR, lane); } }
#endif
#endif
        }
        }
#ifdef PROBE_HOT
        if (l == 0) { xcd_barrier(bar);
            pg8::Gemm g{Hb, (const bf16*)(wl + WL_GU), MT, 512, DM}; pg8::HotOrder S; S.init(MT, 512, G, bx, DM); S.nrounds = PROBE_HOT;
            pg8::EpiPlain E{(bf16*)(ws + WS_END), 512, SLAB};
            pg8::gemm_phase<pg8::EpiPlain, pg8::HotOrder, PG8_ALIGN, PG8_SP2>(lds + RING_OFF, g, S, E, wave0);
        }
#endif
#ifdef PROBE_GU
        if (l == 0) { xcd_barrier(bar);
            pg8::Gemm g{Hb, (const bf16*)(wl + WL_GU), MT, PROBE_GU * 256, DM}; pg8::StaticOrder S; S.init(MT, PROBE_GU * 256, G, bx, DM);
            pg8::EpiPlain E{(bf16*)(ws + WS_END), PROBE_GU * 256, SLAB};
            pg8::gemm_phase<pg8::EpiPlain, pg8::StaticOrder, PG8_ALIGN, PG8_SP2>(lds + RING_OFF, g, S, E, wave0);
        }
#endif
        SEAM(pb + 4);
        for (int rep = 0; rep < ((RP(6) && l == 0) ? 2 : 1); ++rep) { if (rep) xcd_barrier(bar);
        if (IN(pb + 5) && !SK(6)) { PHASE_IDS;
            const float* cw = args.in[18] + (size_t)l * 3 * FFN; const float* cb = args.in[19] + (size_t)l * FFN;
            for (int i = bx * 512 + tid; i < 128 * (FFN / 8); i += G * 512) { const int j = i / (FFN / 8), f = (i - j * (FFN / 8)) * 8;
                const bf16* hb = HALO + (size_t)j * 6 * FFN + f;
                const v4u g0r = *(const GAS v4u*)hb, g1r = *(const GAS v4u*)(hb + FFN), u0r = *(const GAS v4u*)(hb + 2 * FFN), u1r = *(const GAS v4u*)(hb + 3 * FFN);
                v4u q62r = {0u, 0u, 0u, 0u}, q63r = q62r;
                if ((j & 31) != 0) { q62r = *(const GAS v4u*)(hb - 2 * FFN); q63r = *(const GAS v4u*)(hb - FFN); }
                v4u o0, o1;
#pragma unroll
                for (int hf = 0; hf < 2; ++hf) {
#define HX4(R) ((f32x4){bflo(hf ? R.z : R.x), bfhi(hf ? R.z : R.x), bflo(hf ? R.w : R.y), bfhi(hf ? R.w : R.y)})
                    const f32x4 g0 = HX4(g0r), g1 = HX4(g1r), u0 = HX4(u0r), u1 = HX4(u1r), q62 = HX4(q62r), q63 = HX4(q63r);
#undef HX4
                    const int fh = f + 4 * hf;
                    const f32x4 w0 = *(const GAS f32x4*)(cw + fh), w1 = *(const GAS f32x4*)(cw + FFN + fh), w2 = *(const GAS f32x4*)(cw + 2 * FFN + fh), bb = *(const GAS f32x4*)(cb + fh);
                    const f32x4 c0 = w0 * q62 + w1 * q63 + w2 * g0 + bb, c1 = w0 * q63 + w1 * g0 + w2 * g1 + bb;
                    const f32x4 a0 = pg8::gelu4(c0) * u0, a1 = pg8::gelu4(c1) * u1;
                    if (hf == 0) { o0.x = cvtpk(a0[0], a0[1]); o0.y = cvtpk(a0[2], a0[3]); o1.x = cvtpk(a1[0], a1[1]); o1.y = cvtpk(a1[2], a1[3]); }
                    else { o0.z = cvtpk(a0[0], a0[1]); o0.w = cvtpk(a0[2], a0[3]); o1.z = cvtpk(a1[0], a1[1]); o1.w = cvtpk(a1[2], a1[3]); } }
                *(GAS v4u*)(Ab + (size_t)(64 * j) * FFN + f) = o0; *(GAS v4u*)(Ab + (size_t)(64 * j + 1) * FFN + f) = o1; }
        }
        }
        SEAM(pb + 5);
        for (int rep = 0; rep < ((RP(7) && l == 0) ? 2 : 1); ++rep) { if (rep) xcd_barrier(bar);
        if (IN(pb + 6) && !SK(7)) {
            pg8::Gemm g{Ab, (const bf16*)(wl + WL_DN), MT, DM, FFN}; pg8::SplitOrder S; S.init2(NPR, DM, G, bx, FFN);
            pg8::EpiPlain E{MFb, DM, SLAB};
#if DYN_PIECES == 2
            S.pmode = 2;
            pg8::gemm_phase<pg8::EpiPlain, pg8::SplitOrder, PG8_ALIGN, PG8_SP2>(lds + RING_OFF, g, S, E, wave0);
#elif DYN_PIECES
            S.pmode = 0;
            for (;;) { pg8::gemm_phase<pg8::EpiPlain, pg8::SplitOrder, PG8_ALIGN, PG8_SP2>(lds + RING_OFF, g, S, E, wave0);
                if (threadIdx.x == 0) MISC[12] = __hip_atomic_fetch_add(ctl + CW_PIECEQ + 64 * (2 * l + 1), 1u, RLX_AGENT);
                __syncthreads(); const int t = __builtin_amdgcn_readfirstlane((int)MISC[12]); __syncthreads();
                if (t >= 256) break;
                S.c = t; S.pmode = 1; }
#else
            pg8::gemm_phase<pg8::EpiPlain, pg8::SplitOrder, PG8_ALIGN, PG8_SP2>(lds + RING_OFF, g, S, E, wave0);
#endif
        }
        }
        SEAM(pb + 6);
        if (IN(pb + 7) && !SK(8)) { PHASE_IDS;
            if (l + 1 < NLAYER) {
                norm_sample_row<true, true, true>(true, nullptr, XB, SLAB, args.in[14] + l * DM, nullptr, RS, (LAS float*)(lds + 81920), bx, tid);
                norm_rows<true, true, true>(true, nullptr, XB, MFb, args.in[14] + l * DM, nullptr, RS, bx, wave, lane);
            } else {
                norm_sample_row<true, true, false>(false, nullptr, XB, SLAB, args.in[14] + l * DM, out, nullptr, (LAS float*)(lds + 81920), bx, tid);
                norm_rows<true, true, false>(false, nullptr, XB, MFb, args.in[14] + l * DM, out, nullptr, bx, wave, lane);
            }
#ifdef PROBE_SKEW
            if (l + 1 == NLAYER && bx == 0 && wave == 0) {
                const GAS unsigned long long* ts = (const GAS unsigned long long*)(ws + WS_RS + 512 * 1024);
                long long lost = 0;
                for (int k = 0; k < 18; ++k) { if (!(((PROBE_SKEW) >> k) & 1)) continue;
                    const unsigned long long base = ts[k * 256];
                    int mx = -(1 << 30), sm = 0, mxS = -(1 << 30), mnS = 1 << 30;
                    for (int j = 0; j < 4; ++j) { const int c_ = lane + 64 * j; const int dlt = (int)(long long)(ts[k * 256 + c_] - base); mx = dlt > mx ? dlt : mx; sm += dlt;
                        if (c_ >= PROBE_SKEW_REM) { mxS = dlt > mxS ? dlt : mxS; mnS = dlt < mnS ? dlt : mnS; } }
                    for (int o = 32; o > 0; o >>= 1) { const int m2 = __shfl_xor(mx, o); mx = m2 > mx ? m2 : mx; sm += __shfl_xor(sm, o); const int m3 = __shfl_xor(mxS, o); mxS = m3 > mxS ? m3 : mxS; const int m4 = __shfl_xor(mnS, o); mnS = m4 < mnS ? m4 : mnS; }
#if PROBE_SKEW_MODE == 8
                    { int mnA = 1 << 30; for (int j = 0; j < 4; ++j) { const int dlt = (int)(long long)(ts[k * 256 + lane + 64 * j] - base); mnA = dlt < mnA ? dlt : mnA; } for (int o = 32; o > 0; o >>= 1) { const int m2 = __shfl_xor(mnA, o); mnA = m2 < mnA ? m2 : mnA; }
                      lost += (long long)(mx - mnA); }
#elif PROBE_SKEW_MODE == 9
                    lost += (long long)(mxS - (sm / 256));
#elif PROBE_SKEW_MODE == 4
                    lost += (long long)(mx - mxS);
#elif PROBE_SKEW_MODE == 6
                    lost += (long long)(mxS - mnS);
#else
                    lost += (long long)mx - (long long)(sm / 256);
#endif
                }
                if (lost < 0) lost = 0;
                if (lane == 0) { const unsigned long long s0 = rt(), tgt = (unsigned long long)lost * PROBE_SKEW_MULT; while (rt() - s0 < tgt) __builtin_amdgcn_s_sleep(8); }
            }
#endif
        }
        if (l + 1 < NLAYER) SEAM(pb + 7);
    }
#undef IN
#undef SEAM
}

extern "C" void kernel_launch(void* const* d_in, const int* in_sizes, int n_in, void* d_out, int out_size, void* d_ws, size_t ws_size, hipStream_t stream) {
    static int grid = 0;
    if (grid == 0) {
        if (n_in != 20 || (size_t)out_size != O_END || ws_size < WS_END) { fprintf(stderr, "kernel_launch: unexpected shapes: n_in %d out %d ws %zu (need %zu)\n", n_in, out_size, ws_size, (size_t)WS_END); grid = -1; return; }
        int dev = 0, cus = 0, per_cu = 0;
        if (hipGetDevice(&dev) != hipSuccess || hipDeviceGetAttribute(&cus, hipDeviceAttributeMultiprocessorCount, dev) != hipSuccess) { grid = -1; return; }
        if (hipFuncSetAttribute((const void*)fwd_kernel, hipFuncAttributeMaxDynamicSharedMemorySize, LDS_BYTES) != hipSuccess) { fprintf(stderr, "kernel_launch: hipFuncSetAttribute failed\n"); grid = -1; return; }
        if (hipOccupancyMaxActiveBlocksPerMultiprocessor(&per_cu, (const void*)fwd_kernel, NWAVES * 64, LDS_BYTES) != hipSuccess || per_cu < 1) fprintf(stderr, "kernel_launch: occupancy query reports %d\n", per_cu);
        (void)hipGetLastError();
        if (cus < 256) { fprintf(stderr, "kernel_launch: built for a 256-CU device, found %d CUs\n", cus); grid = -1; return; }
        grid = 256;
    }
    if (grid < 0) return;
    if (hipMemsetAsync((char*)d_ws + WS_CTL, 0, CTL_ZERO_BYTES, stream) != hipSuccess) return;
    Args a{};
    for (int i = 0; i < 20; ++i) a.in[i] = (const float*)d_in[i];
    a.out = (float*)d_out; a.ws = (unsigned char*)d_ws;
#if MK_PER_PHASE
    for (int p = 0; p < N_PHASES; ++p) { a.ph_lo = p; a.ph_hi = p + 1; hipLaunchKernelGGL(fwd_kernel, dim3(grid), dim3(NWAVES * 64), LDS_BYTES, stream, a); }
#else
    a.ph_lo = 0; a.ph_hi = N_PHASES;
    hipLaunchKernelGGL(fwd_kernel, dim3(grid), dim3(NWAVES * 64), LDS_BYTES, stream, a);
#endif
}
```
